# Optimizing an MI355X kernel written in HIP

```python
import jax
import jax.numpy as jnp
from jax import lax
import numpy as np

D_MODEL = 2048
BATCH = 2
SEQ = 4096
DEPTH = 1

HEAD_DIM = 128
GDN_HEADS = 8
NSA_HEADS = 8
NSA_KV_HEADS = 2
NSA_GROUP = NSA_HEADS // NSA_KV_HEADS
GDN_WIDTH = GDN_HEADS * HEAD_DIM
NSA_WIDTH = NSA_HEADS * HEAD_DIM
NSA_KV_WIDTH = NSA_KV_HEADS * HEAD_DIM
D_MIX = GDN_WIDTH + NSA_WIDTH
CONV_WIDTH = 4
GDN_CHUNK = 64
CMP_BLOCK = 32
CMP_STRIDE = 16
CMP_HIDDEN = 256
SEL_BLOCK = 64
SEL_TOPK = 16
N_LOCAL_BLOCKS = 2
WINDOW = 512
Q_BLOCK = 128
N_EXPERTS = 64
TOP_K = 8
EXPERT_FF = 512
SHARED_FF = 512
ROUTED_SCALE = 2.5
N_MOD = 6
EPS = 1e-6
IN_SPLIT_SIZES = (3 * GDN_WIDTH, GDN_HEADS, GDN_HEADS, GDN_WIDTH, NSA_WIDTH, 6 * NSA_KV_WIDTH, 3 * NSA_HEADS)
IN_COLS = 4 * GDN_WIDTH + 2 * GDN_HEADS + NSA_WIDTH + 6 * NSA_KV_WIDTH + 3 * NSA_HEADS

kernel_name = "hybrid_gdn_nsa_moe_block"


def rms_norm(x, w):
    xf = x.astype(jnp.float32)
    y = xf * lax.rsqrt(jnp.mean(xf * xf, axis=-1, keepdims=True) + EPS)
    return (y * w.astype(jnp.float32)).astype(x.dtype)


def l2_normalize(x):
    return x * lax.rsqrt(jnp.sum(x * x, axis=-1, keepdims=True) + EPS)


def masked_softmax(s, valid):
    s = jnp.where(valid, s.astype(jnp.float32), -jnp.inf)
    m = jnp.max(s, axis=-1, keepdims=True)
    m = jnp.where(jnp.isfinite(m), m, 0.0)
    e = jnp.exp(s - m)
    return e / jnp.maximum(jnp.sum(e, axis=-1, keepdims=True), 1e-30)


def causal_depthwise_conv(x, w):
    t = x.shape[1]
    xp = jnp.pad(x, ((0, 0), (CONV_WIDTH - 1, 0), (0, 0)))
    return sum(xp[:, i:i + t] * w[i] for i in range(CONV_WIDTH))


def gated_delta_rule(q, k, v, g, beta):
    b, t, h, dk = q.shape
    dv = v.shape[-1]
    c = GDN_CHUNK
    n = t // c

    def to_chunks(a):
        return a.reshape(b, n, c, h, -1).transpose(0, 3, 1, 2, 4)

    q = to_chunks(q) * dk ** -0.5
    k = to_chunks(k)
    v = to_chunks(v)
    beta = beta.reshape(b, n, c, h).transpose(0, 3, 1, 2)
    g_cum = jnp.cumsum(g.reshape(b, n, c, h).transpose(0, 3, 1, 2), axis=-1)
    causal = jnp.tril(jnp.ones((c, c), dtype=bool))
    strict = jnp.tril(jnp.ones((c, c), dtype=bool), -1)
    decay = jnp.exp(jnp.where(causal, g_cum[..., :, None] - g_cum[..., None, :], -jnp.inf))
    k_beta = k * beta[..., None]
    a_strict = jnp.where(strict, jnp.einsum('bhncd,bhnsd->bhncs', k_beta, k) * decay, 0.0)
    lhs = a_strict + jnp.eye(c, dtype=q.dtype)
    rhs = jnp.concatenate([v * beta[..., None], k_beta * jnp.exp(g_cum)[..., None]], axis=-1)
    sol = lax.linalg.triangular_solve(lhs, rhs, left_side=True, lower=True, unit_diagonal=True)
    u, w = sol[..., :dv], sol[..., dv:]
    qk = jnp.einsum('bhncd,bhnsd->bhncs', q, k) * decay
    q_dec = q * jnp.exp(g_cum)[..., None]
    g_last = g_cum[..., -1]
    k_dec = k * jnp.exp(g_last[..., None] - g_cum)[..., None]

    def chunk_step(state, xs):
        q_c, qk_c, u_c, w_c, k_c, gl = xs
        v_new = u_c - jnp.einsum('bhcd,bhde->bhce', w_c, state)
        o_c = jnp.einsum('bhcd,bhde->bhce', q_c, state) + jnp.einsum('bhcs,bhse->bhce', qk_c, v_new)
        state = state * jnp.exp(gl)[..., None, None] + jnp.einsum('bhcd,bhce->bhde', k_c, v_new)
        return state, o_c

    xs = tuple(jnp.moveaxis(a, 2, 0) for a in (q_dec, qk, u, w, k_dec, g_last))
    state0 = jnp.zeros((b, h, dk, dv), jnp.float32)
    _, o = lax.scan(chunk_step, state0, xs)
    return o.transpose(1, 0, 3, 2, 4).reshape(b, t, h, dv)


def gated_deltanet(qkv, beta_logit, a_logit, gate, conv_w, a_log, dt_bias, norm_w):
    b, t, _ = qkv.shape
    dtype = qkv.dtype
    f32 = jnp.float32
    qkv = jax.nn.silu(causal_depthwise_conv(qkv.astype(f32), conv_w.astype(f32)))
    q, k, v = jnp.split(qkv, 3, axis=-1)
    q = l2_normalize(q.reshape(b, t, GDN_HEADS, HEAD_DIM))
    k = l2_normalize(k.reshape(b, t, GDN_HEADS, HEAD_DIM))
    v = v.reshape(b, t, GDN_HEADS, HEAD_DIM)
    beta = jax.nn.sigmoid(beta_logit.astype(f32))
    g = -jnp.exp(a_log.astype(f32)) * jax.nn.softplus(a_logit.astype(f32) + dt_bias.astype(f32))
    o = gated_delta_rule(q, k, v, g, beta)
    o = rms_norm(o, norm_w) * jax.nn.silu(gate.astype(f32).reshape(b, t, GDN_HEADS, HEAD_DIM))
    return o.reshape(b, t, GDN_WIDTH).astype(dtype)


def compress_blocks(x, pe, w1, w2):
    b, t, hk, d = x.shape
    nc = (t - CMP_BLOCK) // CMP_STRIDE + 1
    idx = np.arange(nc)[:, None] * CMP_STRIDE + np.arange(CMP_BLOCK)[None, :]
    blocks = x[:, idx] + pe[:, None, :]
    flat = blocks.transpose(0, 1, 3, 2, 4).reshape(b, nc, hk, CMP_BLOCK * d)
    return jax.nn.silu(flat @ w1) @ w2


def native_sparse_attention(q, k_cmp, v_cmp, k_slc, v_slc, k_win, v_win, gate_logits,
                            pe_k, w1_k, w2_k, pe_v, w1_v, w2_v):
    b, t, _ = q.shape
    dtype = q.dtype
    f32 = jnp.float32
    scale = HEAD_DIM ** -0.5
    qg = q.reshape(b, t, NSA_KV_HEADS, NSA_GROUP, HEAD_DIM)
    k_cmp, v_cmp, k_slc, v_slc, k_win, v_win = [
        a.reshape(b, t, NSA_KV_HEADS, HEAD_DIM) for a in (k_cmp, v_cmp, k_slc, v_slc, k_win, v_win)]
    pos = jnp.arange(t)

    kc = compress_blocks(k_cmp, pe_k, w1_k, w2_k)
    vc = compress_blocks(v_cmp, pe_v, w1_v, w2_v)
    nc = kc.shape[1]
    c_end = np.arange(nc) * CMP_STRIDE + CMP_BLOCK - 1
    s_cmp = jnp.einsum('btkgd,bckd->bkgtc', qg, kc) * scale
    p_cmp = masked_softmax(s_cmp, c_end[None, :] <= pos[:, None])
    o_cmp = jnp.einsum('bkgtc,bckd->btkgd', p_cmp, vc.astype(f32)).reshape(b, t, NSA_HEADS, HEAD_DIM)

    nsel = t // SEL_BLOCK
    n_top = min(SEL_TOPK, nsel)
    c_start = np.arange(nc)[:, None] * CMP_STRIDE
    s_start = np.arange(nsel)[None, :] * SEL_BLOCK
    overlap = ((c_start < s_start + SEL_BLOCK) & (c_start + CMP_BLOCK > s_start)).astype(np.float32)
    importance = jnp.einsum('bkgtc,cj->bktj', p_cmp, overlap)
    cur = pos // SEL_BLOCK
    blk = jnp.arange(nsel)
    dist = cur[:, None] - blk[None, :]
    forced = (blk[None, :] == 0) | ((dist >= 0) & (dist < N_LOCAL_BLOCKS))
    importance = jnp.where(forced, jnp.inf, jnp.where(dist >= 0, importance, -jnp.inf))
    _, sel_idx = lax.top_k(importance, n_top)

    nq = t // Q_BLOCK
    q_blocks = qg.reshape(b, nq, Q_BLOCK, NSA_KV_HEADS, NSA_GROUP, HEAD_DIM).transpose(1, 0, 3, 2, 4, 5)
    idx_blocks = sel_idx.reshape(b, NSA_KV_HEADS, nq, Q_BLOCK, n_top).transpose(2, 0, 1, 3, 4)
    starts = jnp.arange(nq) * Q_BLOCK
    ks_blk = k_slc.reshape(b, nsel, SEL_BLOCK, NSA_KV_HEADS, HEAD_DIM).transpose(0, 3, 1, 2, 4)
    vs_blk = v_slc.reshape(b, nsel, SEL_BLOCK, NSA_KV_HEADS, HEAD_DIM).transpose(0, 3, 1, 2, 4)
    pad = ((0, 0), (0, 0), (WINDOW, 0), (0, 0))
    kw_pad = jnp.pad(k_win.transpose(0, 2, 1, 3), pad)
    vw_pad = jnp.pad(v_win.transpose(0, 2, 1, 3), pad)
    bi = jnp.arange(b)[:, None, None, None]
    hi = jnp.arange(NSA_KV_HEADS)[None, :, None, None]
    n_keys = n_top * SEL_BLOCK

    def query_block(args):
        qb, ib, start = args
        tq = start + jnp.arange(Q_BLOCK)
        ksel = ks_blk[bi, hi, ib].reshape(b, NSA_KV_HEADS, Q_BLOCK, n_keys, HEAD_DIM)
        vsel = vs_blk[bi, hi, ib].reshape(b, NSA_KV_HEADS, Q_BLOCK, n_keys, HEAD_DIM)
        kpos = (ib[..., None] * SEL_BLOCK + jnp.arange(SEL_BLOCK)).reshape(b, NSA_KV_HEADS, Q_BLOCK, n_keys)
        s_sel = jnp.einsum('bkqgd,bkqsd->bkqgs', qb, ksel) * scale
        p_sel = masked_softmax(s_sel, (kpos <= tq[:, None])[:, :, :, None, :])
        o_sel = jnp.einsum('bkqgs,bkqsd->bkqgd', p_sel, vsel.astype(f32))
        kw = lax.dynamic_slice_in_dim(kw_pad, start, Q_BLOCK + WINDOW, axis=2)
        vw = lax.dynamic_slice_in_dim(vw_pad, start, Q_BLOCK + WINDOW, axis=2)
        wpos = start - WINDOW + jnp.arange(Q_BLOCK + WINDOW)
        valid = (wpos[None, :] <= tq[:, None]) & (wpos[None, :] > tq[:, None] - WINDOW) & (wpos[None, :] >= 0)
        s_win = jnp.einsum('bkqgd,bksd->bkqgs', qb, kw) * scale
        p_win = masked_softmax(s_win, valid[:, None, :])
        o_win = jnp.einsum('bkqgs,bksd->bkqgd', p_win, vw.astype(f32))
        return o_sel, o_win

    o_sel, o_win = lax.map(query_block, (q_blocks, idx_blocks, starts))

    def unblock(o):
        return o.transpose(1, 0, 3, 2, 4, 5).reshape(b, t, NSA_HEADS, HEAD_DIM)

    gates = jax.nn.sigmoid(gate_logits.astype(f32)).reshape(b, t, 3, NSA_HEADS)[..., None]
    o = gates[:, :, 0] * o_cmp + gates[:, :, 1] * unblock(o_sel) + gates[:, :, 2] * unblock(o_win)
    return o.reshape(b, t, NSA_WIDTH).astype(dtype)


def moe_ffn(h, router_w, router_bias, w_gate, w_up, w_down, ws_gate, ws_up, ws_down):
    b, t, d = h.shape
    x = h.reshape(b * t, d)
    n_tok = b * t
    scores = jax.nn.sigmoid((x @ router_w).astype(jnp.float32))
    _, top_idx = lax.top_k(scores + router_bias.astype(jnp.float32), TOP_K)
    s_sel = jnp.take_along_axis(scores, top_idx, axis=-1)
    weights = s_sel / jnp.sum(s_sel, axis=-1, keepdims=True) * ROUTED_SCALE
    combine = jnp.zeros((n_tok, N_EXPERTS), jnp.float32).at[jnp.arange(n_tok)[:, None], top_idx].set(weights)

    def expert_step(acc, args):
        wg, wu, wd, cw = args
        y = (jax.nn.silu(x @ wg) * (x @ wu)) @ wd
        return acc + cw[:, None].astype(y.dtype) * y, None

    routed, _ = lax.scan(expert_step, jnp.zeros_like(x), (w_gate, w_up, w_down, combine.T))
    shared = (jax.nn.silu(x @ ws_gate) * (x @ ws_up)) @ ws_down
    return (routed + shared).reshape(b, t, d)


def setup_inputs(seed: int = 0) -> dict:
    key = jax.random.key(seed)
    ks = jax.random.split(key, 32)
    f32 = jnp.float32
    nrm = lambda k, shape, s: jax.random.normal(k, shape, f32) * s
    dt = jnp.exp(jax.random.uniform(ks[8], (DEPTH, GDN_HEADS), f32, np.log(1e-3), np.log(1e-1)))
    return {
        "x": nrm(ks[0], (BATCH, SEQ, D_MODEL), 1.0),
        "c": nrm(ks[1], (BATCH, D_MODEL), 1.0),
        "w_ada": nrm(ks[2], (DEPTH, D_MODEL, N_MOD * D_MODEL), 0.5 * D_MODEL ** -0.5),
        "b_ada": nrm(ks[3], (DEPTH, N_MOD * D_MODEL), 0.01),
        "norm_attn_w": 1.0 + nrm(ks[4], (DEPTH, D_MODEL), 0.02),
        "norm_ffn_w": 1.0 + nrm(ks[5], (DEPTH, D_MODEL), 0.02),
        "norm_final_w": 1.0 + nrm(ks[6], (D_MODEL,), 0.02),
        "w_in": nrm(ks[7], (DEPTH, D_MODEL, IN_COLS), D_MODEL ** -0.5),
        "gdn_conv_w": nrm(ks[9], (DEPTH, CONV_WIDTH, 3 * GDN_WIDTH), CONV_WIDTH ** -0.5),
        "gdn_a_log": jnp.log(jax.random.uniform(ks[10], (DEPTH, GDN_HEADS), f32, 1.0, 16.0)),
        "gdn_dt_bias": dt + jnp.log(-jnp.expm1(-dt)),
        "gdn_norm_w": 1.0 + nrm(ks[11], (DEPTH, HEAD_DIM), 0.02),
        "cmp_pe_k": nrm(ks[12], (DEPTH, CMP_BLOCK, HEAD_DIM), 0.02),
        "cmp_w1_k": nrm(ks[13], (DEPTH, CMP_BLOCK * HEAD_DIM, CMP_HIDDEN), (CMP_BLOCK * HEAD_DIM) ** -0.5),
        "cmp_w2_k": nrm(ks[14], (DEPTH, CMP_HIDDEN, HEAD_DIM), CMP_HIDDEN ** -0.5),
        "cmp_pe_v": nrm(ks[15], (DEPTH, CMP_BLOCK, HEAD_DIM), 0.02),
        "cmp_w1_v": nrm(ks[16], (DEPTH, CMP_BLOCK * HEAD_DIM, CMP_HIDDEN), (CMP_BLOCK * HEAD_DIM) ** -0.5),
        "cmp_w2_v": nrm(ks[17], (DEPTH, CMP_HIDDEN, HEAD_DIM), CMP_HIDDEN ** -0.5),
        "w_out": nrm(ks[18], (DEPTH, D_MIX, D_MODEL), D_MIX ** -0.5),
        "router_w": nrm(ks[19], (DEPTH, D_MODEL, N_EXPERTS), D_MODEL ** -0.5),
        "router_bias": nrm(ks[20], (DEPTH, N_EXPERTS), 0.01),
        "expert_w_gate": nrm(ks[21], (DEPTH, N_EXPERTS, D_MODEL, EXPERT_FF), D_MODEL ** -0.5),
        "expert_w_up": nrm(ks[22], (DEPTH, N_EXPERTS, D_MODEL, EXPERT_FF), D_MODEL ** -0.5),
        "expert_w_down": nrm(ks[23], (DEPTH, N_EXPERTS, EXPERT_FF, D_MODEL), EXPERT_FF ** -0.5),
        "shared_w_gate": nrm(ks[24], (DEPTH, D_MODEL, SHARED_FF), D_MODEL ** -0.5),
        "shared_w_up": nrm(ks[25], (DEPTH, D_MODEL, SHARED_FF), D_MODEL ** -0.5),
        "shared_w_down": nrm(ks[26], (DEPTH, SHARED_FF, D_MODEL), SHARED_FF ** -0.5),
    }


def reference(x, c, w_ada, b_ada, norm_attn_w, norm_ffn_w, norm_final_w, w_in, gdn_conv_w, gdn_a_log,
              gdn_dt_bias, gdn_norm_w, cmp_pe_k, cmp_w1_k, cmp_w2_k, cmp_pe_v, cmp_w1_v, cmp_w2_v, w_out,
              router_w, router_bias, expert_w_gate, expert_w_up, expert_w_down, shared_w_gate, shared_w_up,
              shared_w_down):
    cond = jax.nn.silu(c)
    split_points = [int(p) for p in np.cumsum(IN_SPLIT_SIZES)[:-1]]
    for l in range(DEPTH):
        mod = cond @ w_ada[l] + b_ada[l]
        shift_a, scale_a, gate_a, shift_m, scale_m, gate_m = [m[:, None, :] for m in jnp.split(mod, N_MOD, axis=-1)]
        h = rms_norm(x, norm_attn_w[l]) * (1.0 + scale_a) + shift_a
        proj = h @ w_in[l]
        qkv_g, beta_g, a_g, gate_g, q_n, kv_n, gate_n = jnp.split(proj, split_points, axis=-1)
        k_cmp, v_cmp, k_slc, v_slc, k_win, v_win = jnp.split(kv_n, 6, axis=-1)
        y_gdn = gated_deltanet(qkv_g, beta_g, a_g, gate_g, gdn_conv_w[l], gdn_a_log[l], gdn_dt_bias[l], gdn_norm_w[l])
        y_nsa = native_sparse_attention(q_n, k_cmp, v_cmp, k_slc, v_slc, k_win, v_win, gate_n,
                                        cmp_pe_k[l], cmp_w1_k[l], cmp_w2_k[l], cmp_pe_v[l], cmp_w1_v[l], cmp_w2_v[l])
        x = x + gate_a * (jnp.concatenate([y_gdn, y_nsa], axis=-1) @ w_out[l])
        h = rms_norm(x, norm_ffn_w[l]) * (1.0 + scale_m) + shift_m
        x = x + gate_m * moe_ffn(h, router_w[l], router_bias[l], expert_w_gate[l], expert_w_up[l], expert_w_down[l],
                                 shared_w_gate[l], shared_w_up[l], shared_w_down[l])
    return rms_norm(x, norm_final_w)
```

```cpp
#include <hip/hip_runtime.h>
#include <stdint.h>

typedef unsigned short bf16_t;
typedef short bf16x8 __attribute__((ext_vector_type(8)));
typedef float f32x4 __attribute__((ext_vector_type(4)));
typedef float f32x16 __attribute__((ext_vector_type(16)));

extern __shared__ __attribute__((aligned(16))) unsigned char dyn_smem[];
constexpr int LDS_BYTES_C = 152 * 1024;
__device__ __forceinline__ unsigned char* dyn_smem_base() { return dyn_smem; }
constexpr int NB = 2, T = 4096, NTOK = NB * T, D = 2048;
constexpr int PROJ_LD = 6912;
constexpr int C_QKV = 0, C_GATEG = 3072, C_QN = 4096, C_KCMP = 5120, C_VCMP = 5376, C_KSLC = 5632, C_VSLC = 5888, C_KWIN = 6144, C_VWIN = 6400, C_SMALL = 6656;
constexpr int NEXP = 64, EFF = 512, TOPK = 8;
constexpr int NROWS_MOE = NTOK * TOPK + NTOK;
constexpr int NTHR = 512;

constexpr size_t al256(size_t x) { return (x + 255) & ~(size_t)255; }
constexpr size_t OFF_CTRL = 0;
constexpr size_t CTRL_BYTES = 65536;
constexpr size_t OFF_MOD = OFF_CTRL + CTRL_BYTES;
constexpr size_t OFF_BIAS1 = al256(OFF_MOD + 2 * 12288 * 4);
constexpr size_t OFF_EGL = al256(OFF_BIAS1 + 2 * 256 * 4);
constexpr size_t OFF_X1 = al256(OFF_EGL + 1024 * 4);
constexpr size_t OFF_TKIDX = al256(OFF_X1 + (size_t)NTOK * D * 4);
constexpr size_t OFF_TKW = al256(OFF_TKIDX + (size_t)NTOK * 8 * 4);
constexpr size_t OFF_SLOT = al256(OFF_TKW + (size_t)NTOK * 8 * 4);
constexpr size_t OFF_POS = al256(OFF_SLOT + (size_t)NTOK * 8 * 4);
constexpr size_t OFF_STOK = al256(OFF_POS + (size_t)NTOK * 8 * 4);
constexpr size_t OFF_ROWW = al256(OFF_STOK + (size_t)(NROWS_MOE + 256) * 4);
constexpr size_t OFF_ACT = al256(OFF_ROWW + (size_t)(NROWS_MOE + 256) * 4);
constexpr size_t OFF_DNT = al256(OFF_ACT + (size_t)(NROWS_MOE + 256) * EFF * 2);
constexpr size_t OFF_REGB = al256(OFF_DNT + (size_t)65 * 2048 * 512 * 2);
constexpr size_t OFF_Y = OFF_REGB;
constexpr size_t OFF_WINT = OFF_REGB;
constexpr size_t OFF_WOUTT = al256(OFF_WINT + (size_t)PROJ_LD * D * 2);
constexpr size_t OFF_W1T = al256(OFF_WOUTT + (size_t)D * D * 2);
constexpr size_t OFF_W2T = al256(OFF_W1T + (size_t)2 * 256 * 4096 * 2);
constexpr size_t OFF_GUT = al256(OFF_W2T + (size_t)2 * 128 * 256 * 2);
constexpr size_t OFF_H = al256(OFF_GUT + (size_t)65 * 1024 * 2048 * 2);
constexpr size_t OFF_PROJ = al256(OFF_H + (size_t)NTOK * D * 2);
constexpr size_t OFF_SMALL = al256(OFF_PROJ + (size_t)NTOK * PROJ_LD * 2);
constexpr size_t OFF_GNEGW = al256(OFF_SMALL + (size_t)NTOK * 64 * 4);
constexpr size_t OFF_GQD = al256(OFF_GNEGW + (size_t)1024 * 64 * 128 * 2);
constexpr size_t OFF_GKDT = al256(OFF_GQD + (size_t)1024 * 64 * 128 * 2);
constexpr size_t OFF_GQK = al256(OFF_GKDT + (size_t)1024 * 128 * 64 * 2);
constexpr size_t OFF_GUT2 = al256(OFF_GQK + (size_t)1024 * 64 * 64 * 2);
constexpr size_t OFF_FLAT = al256(OFF_GUT2 + (size_t)1024 * 128 * 64 * 4);
constexpr size_t OFF_HID = al256(OFF_FLAT + (size_t)2 * 1024 * 4096 * 2);
constexpr size_t OFF_KVC = al256(OFF_HID + (size_t)2 * 1024 * 256 * 2);
constexpr size_t OFF_YCAT = al256(OFF_KVC + (size_t)2 * 1024 * 128 * 2);
constexpr size_t OFF_GSB = al256(OFF_YCAT + (size_t)NTOK * D * 2);
constexpr size_t OFF_GVB = al256(OFF_GSB + (size_t)1024 * 8 * 4 * 64 * 16);
constexpr size_t OFF_RWP = al256(OFF_GVB + (size_t)1024 * 8 * 2 * 64 * 16);
constexpr size_t WS_END = al256(OFF_RWP + (size_t)2048 * 64 * 4);
static_assert(OFF_Y + (size_t)NROWS_MOE * 2048 * 2 <= WS_END, "y must fit region B");
static_assert(WS_END <= (size_t)1073741824, "workspace over 1 GiB");

constexpr int CW_CNT = 4096;
constexpr int CW_Q0 = 4352;

struct Params {
    const float *x, *c, *w_ada, *b_ada, *norm_attn_w, *norm_ffn_w, *norm_final_w, *w_in, *conv_w, *a_log, *dt_bias, *gdn_norm_w;
    const float *pe_k, *w1_k, *w2_k, *pe_v, *w1_v, *w2_v, *w_out, *router_w, *router_bias, *e_gate, *e_up, *e_down, *s_gate, *s_up, *s_down;
    float* out;
    unsigned char* ws;
};

typedef __bf16 bf16x2_t __attribute__((ext_vector_type(2)));
typedef float f32x2_t __attribute__((ext_vector_type(2)));
__device__ __forceinline__ unsigned pack2(float lo, float hi) { const f32x2_t v = {lo, hi}; return __builtin_bit_cast(unsigned, __builtin_convertvector(v, bf16x2_t)); }
__device__ __forceinline__ bf16_t f2bf(float f) { return __builtin_bit_cast(unsigned short, (__bf16)f); }
__device__ __forceinline__ float bf2f(bf16_t b) { return __uint_as_float(((unsigned)b) << 16); }
__device__ __forceinline__ float silu_f(float x) { return x / (1.f + __expf(-x)); }
__device__ __forceinline__ float sigmoid_f(float x) { return 1.f / (1.f + __expf(-x)); }
__device__ __forceinline__ float softplus_f(float x) { return fmaxf(x, 0.f) + log1pf(__expf(-fabsf(x))); }
__device__ __forceinline__ int perm32(int dl) { return 8 * ((dl >> 2) & 3) + 4 * (dl >> 4) + (dl & 3); }
__device__ __forceinline__ int perm16(int kl) { return 8 * ((kl >> 2) & 1) + 4 * (kl >> 3) + (kl & 3); }
__device__ __forceinline__ int opaque(int x) { asm volatile("" : "+v"(x)); return x; }
#define LDS_BARRIER() do { __builtin_amdgcn_fence(__ATOMIC_RELEASE, "wavefront"); __builtin_amdgcn_s_waitcnt(0xc07f)  ; __builtin_amdgcn_s_barrier(); __builtin_amdgcn_fence(__ATOMIC_ACQUIRE, "wavefront"); } while (0)
#define MFMA32(a, b, c) __builtin_amdgcn_mfma_f32_32x32x16_bf16((a), (b), (c), 0, 0, 0)
__device__ __forceinline__ float wave_sum(float v) {
#pragma unroll
    for (int o = 32; o > 0; o >>= 1) v += __shfl_xor(v, o);
    return v;
}


#define XB_TMO      128
#define XB_XCNT(j)  (256  + 64 * (j))
#define XB_XSUB(j)  (1280 + 64 * (j))
#define XB_XGEN(j)  (2304 + 64 * (j))
#define XB_TOP      3328
#define XB_TOPGEN   3392
#define XCD_BAR_WORDS 3456
#define XB_SPIN_CAP (1u << 18)
#define LAS __attribute__((address_space(3)))

__device__ __forceinline__ unsigned xb_ld(unsigned* p)              { return __hip_atomic_load(p, __ATOMIC_RELAXED, __HIP_MEMORY_SCOPE_AGENT); }
__device__ __forceinline__ unsigned xb_add(unsigned* p, unsigned v) { return __hip_atomic_fetch_add(p, v, __ATOMIC_RELAXED, __HIP_MEMORY_SCOPE_AGENT); }
__device__ __forceinline__ unsigned xb_xcc_id() { return (unsigned)__builtin_amdgcn_s_getreg((3 << 11) | 20) & 0xFu; }
#define XB_SPIN(cond, bar) do { unsigned _sp = 0; while (cond) { __builtin_amdgcn_s_sleep(1); \
    if ((++_sp & 255u) == 0u) { if (xb_ld(&(bar)[XB_TMO])) break; if (_sp > XB_SPIN_CAP) { atomicAdd(&(bar)[XB_TMO], 1u); break; } } } } while (0)

struct XcdBarrier {
    unsigned* bar; unsigned x;
    volatile LAS unsigned* st;
};

__device__ __forceinline__ XcdBarrier xcd_barrier_post(unsigned* bar, volatile LAS unsigned* st) {
    XcdBarrier b; b.bar = bar; b.x = xb_xcc_id(); b.st = st;
    if (threadIdx.x == 0) (void)xb_add(&bar[XB_XCNT(b.x)], 1u);
    return b;
}
__device__ __forceinline__ void xcd_barrier_complete(unsigned* bar, unsigned x, unsigned& nloc, unsigned& nx) {
    const unsigned G = gridDim.x * gridDim.y * gridDim.z;
    unsigned sum, cnt, mine, sp = 0u;
    for (;;) {
        sum = 0u; cnt = 0u; mine = 0u;
#pragma unroll
        for (unsigned j = 0; j < 16; ++j) { const unsigned c = xb_ld(&bar[XB_XCNT(j)]); sum += c; cnt += (c > 0u) ? 1u : 0u; mine = (j == x) ? c : mine; }
        if (sum == G) break;
        __builtin_amdgcn_s_sleep(1);
        if ((++sp & 255u) == 0u) { if (xb_ld(&bar[XB_TMO])) break; if (sp > XB_SPIN_CAP) { atomicAdd(&bar[XB_TMO], 1u); break; } }
    }
    nloc = mine > 0u ? mine : 1u; nx = cnt > 0u ? cnt : 1u;
}

__device__ __forceinline__ void xcd_barrier(const XcdBarrier& b) {
    asm volatile("s_waitcnt vmcnt(0)" ::: "memory");
    __syncthreads();
    if (threadIdx.x == 0) {
        unsigned* bar = b.bar;
        __builtin_amdgcn_s_waitcnt(0);
        unsigned nloc = b.st[0], nx = b.st[1];
        if (nloc == 0u) { xcd_barrier_complete(bar, b.x, nloc, nx); b.st[0] = nloc; b.st[1] = nx; }
        const unsigned old = xb_add(&bar[XB_XSUB(b.x)], 1u);
        const unsigned gen = old / nloc;
        if (old + 1u == (gen + 1u) * nloc) {
            __builtin_amdgcn_fence(__ATOMIC_RELEASE, "agent");
            asm volatile("s_waitcnt vmcnt(0)" ::: "memory");
            const unsigned og = xb_add(&bar[XB_TOP], 1u);
            const unsigned tg = og / nx;
            if (og + 1u == (tg + 1u) * nx) xb_add(&bar[XB_TOPGEN], 1u);
            else XB_SPIN(xb_ld(&bar[XB_TOPGEN]) == tg, bar);
            __builtin_amdgcn_fence(__ATOMIC_ACQUIRE, "agent");
            xb_add(&bar[XB_XGEN(b.x)], 1u);
            asm volatile("s_waitcnt vmcnt(0)" ::: "memory");
        } else {
            XB_SPIN(xb_ld(&bar[XB_XGEN(b.x)]) == gen, bar);
            __builtin_amdgcn_fence(__ATOMIC_ACQUIRE, "agent");
            asm volatile("s_waitcnt vmcnt(0)" ::: "memory");
        }
    }
    __syncthreads();
}

struct ColFn { const float* p0; const float* p1; int mode; };
__device__ __forceinline__ const float* colptr(const ColFn& f, int n) {
    if (f.mode == 0) return f.p0 + n;
    if (f.mode == 1) {
        int src;
        if (n < 3072) src = n; else if (n < 6656) src = n + 16; else if (n < 6672) src = 3072 + (n - 6656); else if (n < 6696) src = n; else return nullptr;
        return f.p0 + src;
    }
    const int jb = n >> 8, wi = n & 255;
    const long long dlt = (wi < 128) ? 0ll : (long long)(f.p1 - f.p0);
    return f.p0 + dlt + jb * 128 + (wi & 127);
}
struct TileRegs { f32x4 v[8]; };
__device__ __forceinline__ void tp_load(const ColFn& f, int ld_src, int n0, int k0, int tid, TileRegs& r) {
    const int c4 = tid & 31, rp = tid >> 5;
    const float* cp = colptr(f, n0 + 4 * c4);
#pragma unroll
    for (int p = 0; p < 4; ++p)
#pragma unroll
        for (int q = 0; q < 2; ++q) { const int k = k0 + 32 * p + 2 * rp + q; r.v[2 * p + q] = cp ? *(const f32x4*)(cp + (size_t)k * ld_src) : (f32x4){0.f, 0.f, 0.f, 0.f}; }
}
__device__ __forceinline__ void tp_store(const TileRegs& r, bf16_t* dst, int ld_dst, int n0, int k0, int tid, unsigned* tile) {
    const int c4 = tid & 31, rp = tid >> 5;
#pragma unroll
    for (int p = 0; p < 4; ++p)
#pragma unroll
        for (int i = 0; i < 4; ++i) tile[(4 * c4 + i) * 65 + 16 * p + rp] = pack2(r.v[2 * p][i], r.v[2 * p + 1][i]);
    LDS_BARRIER();
    { const int n = tid >> 2, q = tid & 3; const unsigned* tp = tile + n * 65 + q * 16;
      unsigned* dp = (unsigned*)(dst + (size_t)(n0 + n) * ld_dst + k0 + q * 32);
#pragma unroll
      for (int j = 0; j < 4; ++j) { uint4 o; o.x = tp[4 * j]; o.y = tp[4 * j + 1]; o.z = tp[4 * j + 2]; o.w = tp[4 * j + 3]; *(uint4*)(dp + 4 * j) = o; } }
    LDS_BARRIER();
}

constexpr int J_WIN = 54 * 16, J_WOUT = 16 * 16, J_W1 = 2 * 2 * 32, J_W2 = 2 * 2, J_GU = 65 * 8 * 16, J_DN = 65 * 16 * 4;
constexpr int J_TP = J_WIN + J_WOUT + J_W1 + J_W2 + J_GU + J_DN;
constexpr int J_EARLY = J_WIN + J_WOUT + J_W1 + J_W2;
struct TpJob { ColFn f; int ld_src; bf16_t* dst; int ld_dst, n0, k0; };
__device__ __forceinline__ void tp_decode(const Params& p, int j, TpJob& t) {
    if (j < J_WIN) { t.f = ColFn{p.w_in, nullptr, 1}; t.ld_src = 6696; t.dst = (bf16_t*)(p.ws + OFF_WINT); t.ld_dst = 2048; t.n0 = (j >> 4) * 128; t.k0 = (j & 15) * 128; return; }
    j -= J_WIN;
    if (j < J_WOUT) { t.f = ColFn{p.w_out, nullptr, 0}; t.ld_src = 2048; t.dst = (bf16_t*)(p.ws + OFF_WOUTT); t.ld_dst = 2048; t.n0 = (j >> 4) * 128; t.k0 = (j & 15) * 128; return; }
    j -= J_WOUT;
    if (j < J_W1) { const int which = j >> 6, r = j & 63; const float* w = p.w1_k + (which ? (long long)(p.w1_v - p.w1_k) : 0ll);
        t.f = ColFn{w, nullptr, 0}; t.ld_src = 256; t.dst = (bf16_t*)(p.ws + OFF_W1T) + (size_t)which * 256 * 4096; t.ld_dst = 4096; t.n0 = (r >> 5) * 128; t.k0 = (r & 31) * 128; return; }
    j -= J_W1;
    if (j < J_W2) { const int which = j >> 1, r = j & 1; const float* w = p.w2_k + (which ? (long long)(p.w2_v - p.w2_k) : 0ll);
        t.f = ColFn{w, nullptr, 0}; t.ld_src = 128; t.dst = (bf16_t*)(p.ws + OFF_W2T) + (size_t)which * 128 * 256; t.ld_dst = 256; t.n0 = 0; t.k0 = r * 128; return; }
    j -= J_W2;
    if (j < J_GU) { const int e = j >> 7, r = j & 127;
        const float* g0 = p.e_gate + (e < 64 ? (long long)e * 2048 * 512 : (long long)(p.s_gate - p.e_gate));
        const float* g1 = p.e_up + (e < 64 ? (long long)e * 2048 * 512 : (long long)(p.s_up - p.e_up));
        t.f = ColFn{g0, g1, 2}; t.ld_src = 512; t.dst = (bf16_t*)(p.ws + OFF_GUT) + (size_t)e * 1024 * 2048; t.ld_dst = 2048; t.n0 = (r & 7) * 128; t.k0 = (r >> 3) * 128; return; }
    j -= J_GU;
    { const int e = j >> 6, r = j & 63;
        const float* g0 = p.e_down + (e < 64 ? (long long)e * 512 * 2048 : (long long)(p.s_down - p.e_down));
        t.f = ColFn{g0, nullptr, 0}; t.ld_src = 2048; t.dst = (bf16_t*)(p.ws + OFF_DNT) + (size_t)e * 2048 * 512; t.ld_dst = 512; t.n0 = (r & 15) * 128; t.k0 = (r >> 4) * 128; }
}

constexpr int J_MOD = 192, J_B1 = 8;
__device__ __forceinline__ void phase_prologue(const Params& p, int bid, int nb, unsigned char* smem) {
    float* sf = (float*)smem;
    const int tid = opaque((int)threadIdx.x);
    for (int j = bid; j < J_MOD; j += nb) {
        float* sc = sf;
        float* red = sf + 4096;
        for (int i = tid; i < 4096; i += NTHR) sc[i] = silu_f(p.c[i]);
        __syncthreads();
        const int cg = tid & 15, kl = tid >> 4, j0 = j * 64 + cg * 4;
        float a0[4] = {0, 0, 0, 0}, a1[4] = {0, 0, 0, 0};
        for (int kb = 0; kb < 2048; kb += 256) {
            f32x4 w[8];
#pragma unroll
            for (int u = 0; u < 8; ++u) w[u] = *(const f32x4*)(p.w_ada + (size_t)(kb + 32 * u + kl) * 12288 + j0);
#pragma unroll
            for (int u = 0; u < 8; ++u) { const float c0 = sc[kb + 32 * u + kl], c1 = sc[2048 + kb + 32 * u + kl];
#pragma unroll
                for (int q = 0; q < 4; ++q) { a0[q] += c0 * w[u][q]; a1[q] += c1 * w[u][q]; } }
        }
#pragma unroll
        for (int q = 0; q < 4; ++q) { red[(kl * 16 + cg) * 8 + q] = a0[q]; red[(kl * 16 + cg) * 8 + 4 + q] = a1[q]; }
        __syncthreads();
        if (tid < 128) {
            const int b = tid >> 6, col = tid & 63, cg2 = col >> 2, q = col & 3;
            float s = 0.f;
            for (int k2 = 0; k2 < 32; ++k2) s += red[(k2 * 16 + cg2) * 8 + b * 4 + q];
            ((float*)(p.ws + OFF_MOD))[b * 12288 + j * 64 + col] = s + p.b_ada[j * 64 + col];
        }
        __syncthreads();
    }
    for (int j = (bid + nb - (J_MOD % nb)) % nb; j < J_B1; j += nb) {
        const int which = j >> 2, jb = j & 3;
        const float* pe = p.pe_k + (which ? (long long)(p.pe_v - p.pe_k) : 0ll);
        const float* w1 = p.w1_k + (which ? (long long)(p.w1_v - p.w1_k) : 0ll);
        const int col = tid & 63, kl = tid >> 6;
        float acc = 0.f;
#pragma unroll 8
        for (int kk = kl; kk < 4096; kk += 8) acc += pe[kk] * w1[(size_t)kk * 256 + jb * 64 + col];
        sf[kl * 64 + col] = acc;
        __syncthreads();
        if (tid < 64) { float s = 0.f; for (int k2 = 0; k2 < 8; ++k2) s += sf[k2 * 64 + tid]; ((float*)(p.ws + OFF_BIAS1))[which * 256 + jb * 64 + tid] = s; }
        __syncthreads();
    }
    { float* rwp = (float*)(p.ws + OFF_RWP);
      for (int i = bid * NTHR + tid; i < 2048 * 64; i += nb * NTHR) { const int k = i >> 6, c = i & 63; rwp[i] = p.router_w[(size_t)k * 64 + 16 * (c & 3) + (c >> 2)]; } }
    {
        unsigned* tile = (unsigned*)smem;
        int j = bid;
        TpJob cur; TileRegs rc;
        if (j < J_EARLY) { tp_decode(p, j, cur); tp_load(cur.f, cur.ld_src, cur.n0, cur.k0, tid, rc); }
        while (j < J_EARLY) {
            const int jn = j + nb;
            TpJob nxt; TileRegs rn;
            if (jn < J_EARLY) { tp_decode(p, jn, nxt); tp_load(nxt.f, nxt.ld_src, nxt.n0, nxt.k0, tid, rn); }
            tp_store(rc, cur.dst, cur.ld_dst, cur.n0, cur.k0, tid, tile);
            cur = nxt; rc = rn; j = jn;
        }
    }
}

__device__ __forceinline__ int ec_next_id(unsigned* qhead, LAS int* qs) {
    int nx = qs[3];
    if (nx >= qs[4]) { nx = J_EARLY + 8 * (int)__hip_atomic_fetch_add(qhead, 1u, __ATOMIC_RELAXED, __HIP_MEMORY_SCOPE_AGENT); qs[4] = nx + 8; }
    qs[3] = nx + 1;
    return nx;
}
__device__ __forceinline__ void phase_expert_convert(const Params& p, unsigned* qhead, unsigned char* smem, int budget = 1 << 30) {
    unsigned* tile = (unsigned*)smem; LAS int* qslot = (LAS int*)(dyn_smem_base() + LDS_BYTES_C - 128);
    const int tid = opaque((int)threadIdx.x);
    __syncthreads();
    if (tid == 0) { for (int i = 0; i < 3; ++i) qslot[i] = ec_next_id(qhead, qslot); }
    __syncthreads();
    int j0 = qslot[0], j1 = qslot[1], j2 = qslot[2];
    __syncthreads();
    TpJob t0, t1, t2; TileRegs r0, r1, r2;
    if (j0 < J_TP) { tp_decode(p, j0, t0); tp_load(t0.f, t0.ld_src, t0.n0, t0.k0, tid, r0); }
    if (j1 < J_TP) { tp_decode(p, j1, t1); tp_load(t1.f, t1.ld_src, t1.n0, t1.k0, tid, r1); }
    if (j2 < J_TP) { tp_decode(p, j2, t2); tp_load(t2.f, t2.ld_src, t2.n0, t2.k0, tid, r2); }
#define EC_STEP(jX, tX, rX) do { \
        if (tid == 0) qslot[0] = (--budget > 0) ? ec_next_id(qhead, qslot) : J_TP; \
        tp_store(rX, tX.dst, tX.ld_dst, tX.n0, tX.k0, tid, tile);                  \
        jX = qslot[0]; \
        LDS_BARRIER(); \
        if (jX < J_TP) { tp_decode(p, jX, tX); tp_load(tX.f, tX.ld_src, tX.n0, tX.k0, tid, rX); } } while (0)
    for (;;) {
        if (j0 >= J_TP) break; EC_STEP(j0, t0, r0);
        if (j1 >= J_TP) break; EC_STEP(j1, t1, r1);
        if (j2 >= J_TP) break; EC_STEP(j2, t2, r2);
    }
    if (j0 < J_TP) tp_store(r0, t0.dst, t0.ld_dst, t0.n0, t0.k0, tid, tile);
    if (j1 < J_TP) tp_store(r1, t1.dst, t1.ld_dst, t1.n0, t1.k0, tid, tile);
    if (j2 < J_TP) tp_store(r2, t2.dst, t2.ld_dst, t2.n0, t2.k0, tid, tile);
#undef EC_STEP
}

__device__ __forceinline__ bool expert_convert_one(const Params& p, unsigned* qhead, unsigned char* smem) {
    unsigned* tile = (unsigned*)smem; LAS int* qslot = (LAS int*)(dyn_smem_base() + LDS_BYTES_C - 128);
    const int tid = opaque((int)threadIdx.x);
    if (tid == 0) qslot[0] = ec_next_id(qhead, qslot);
    __syncthreads();
    const int j = qslot[0];
    __syncthreads();
    if (j >= J_TP) return false;
    TpJob cur; TileRegs rc;
    tp_decode(p, j, cur); tp_load(cur.f, cur.ld_src, cur.n0, cur.k0, tid, rc);
    tp_store(rc, cur.dst, cur.ld_dst, cur.n0, cur.k0, tid, tile);
    return true;
}
__device__ __forceinline__ void xcd_barrier_work(const XcdBarrier& b, const Params& p, unsigned* qhead, unsigned char* smem) {
    asm volatile("s_waitcnt vmcnt(0)" ::: "memory");
    __syncthreads();
    LAS unsigned* wf = (LAS unsigned*)(dyn_smem_base() + LDS_BYTES_C - 80);
    if (threadIdx.x == 0) {
        unsigned* bar = b.bar;
        __builtin_amdgcn_s_waitcnt(0);
        unsigned nloc = b.st[0], nx = b.st[1];
        if (nloc == 0u) { xcd_barrier_complete(bar, b.x, nloc, nx); b.st[0] = nloc; b.st[1] = nx; }
        const unsigned old = xb_add(&bar[XB_XSUB(b.x)], 1u);
        const unsigned gen = old / nloc;
        if (old + 1u == (gen + 1u) * nloc) {
            __builtin_amdgcn_fence(__ATOMIC_RELEASE, "agent");
            asm volatile("s_waitcnt vmcnt(0)" ::: "memory");
            const unsigned og = xb_add(&bar[XB_TOP], 1u);
            const unsigned tg = og / nx;
            if (og + 1u == (tg + 1u) * nx) xb_add(&bar[XB_TOPGEN], 1u);
            else XB_SPIN(xb_ld(&bar[XB_TOPGEN]) == tg, bar);
            __builtin_amdgcn_fence(__ATOMIC_ACQUIRE, "agent");
            xb_add(&bar[XB_XGEN(b.x)], 1u);
            asm volatile("s_waitcnt vmcnt(0)" ::: "memory");
            wf[0] = 1u;
        } else { wf[0] = 0u; wf[1] = gen; }
    }
    __syncthreads();
    if (wf[0] == 0u) {
        const unsigned gen = wf[1];
        bool more = true; unsigned spins = 0u;
        for (;;) {
            if (threadIdx.x == 0) { unsigned rel = (xb_ld(&b.bar[XB_XGEN(b.x)]) != gen) ? 1u : 0u;
                if (!rel && (++spins > XB_SPIN_CAP || ((spins & 255u) == 0u && xb_ld(&b.bar[XB_TMO])))) { if (spins > XB_SPIN_CAP) atomicAdd(&b.bar[XB_TMO], 1u); rel = 1u; }
                wf[2] = rel; }
            __syncthreads();
            const unsigned rel = wf[2];
            __syncthreads();
            if (rel) break;
            if (more) more = expert_convert_one(p, qhead, smem); else __builtin_amdgcn_s_sleep(4);
        }
        if (threadIdx.x == 0) {
            __builtin_amdgcn_fence(__ATOMIC_ACQUIRE, "agent");
            asm volatile("s_waitcnt vmcnt(0)" ::: "memory");
        }
    }
    __syncthreads();
}

__device__ __forceinline__ void phase_modulate(const float* xin, const float* nw, const float* mod, int shift_idx, int scale_idx, bf16_t* hout, int bid, int nb) {
    const int tid_ = opaque((int)threadIdx.x); const int lane0 = tid_ & 63, wv = tid_ >> 6;
    for (int row = bid * 8 + wv; row < NTOK; row += nb * 8) {
        const int b = row / T; const int lane = opaque(lane0);
        const float* xr = xin + (size_t)row * D;
        f32x4 v[8]; float ss = 0.f;
#pragma unroll
        for (int c = 0; c < 8; ++c) { v[c] = *(const f32x4*)(xr + (c * 64 + lane) * 4); ss += v[c][0] * v[c][0] + v[c][1] * v[c][1] + v[c][2] * v[c][2] + v[c][3] * v[c][3]; }
        ss = wave_sum(ss);
        const float rstd = rsqrtf(ss * (1.f / D) + 1e-6f);
        const float* sh = mod + b * 12288 + shift_idx * 2048; const float* sc = mod + b * 12288 + scale_idx * 2048;
#pragma unroll
        for (int c = 0; c < 8; ++c) { const int col = (c * 64 + lane) * 4;
            const f32x4 w = *(const f32x4*)(nw + col), s1 = *(const f32x4*)(sc + col), s0 = *(const f32x4*)(sh + col);
            float o[4];
#pragma unroll
            for (int q = 0; q < 4; ++q) o[q] = v[c][q] * rstd * w[q] * (1.f + s1[q]) + s0[q];
            uint2 pk; pk.x = pack2(o[0], o[1]); pk.y = pack2(o[2], o[3]);
            *(uint2*)(hout + (size_t)row * D + col) = pk; }
    }
}

struct ARowDirect { const bf16_t* A; int lda; __device__ __forceinline__ const bf16_t* ptr(int r, int k) const { return A + (size_t)r * lda + k; } };
struct ARowWin { const bf16_t* proj; int col0; __device__ __forceinline__ const bf16_t* ptr(int r, int k) const { const int b = r >> 9, kvh = (r >> 8) & 1; int c = r & 255; c = c < 255 ? c : 254;
        return proj + (size_t)(b * T + 16 * c + (k >> 7)) * PROJ_LD + col0 + kvh * 128 + (k & 127); } };
struct ARowGather { const bf16_t* A; int lda; const int* idx; int rlast; __device__ __forceinline__ const bf16_t* ptr(int r, int k) const { return A + (size_t)idx[r < rlast ? r : rlast] * lda + k; } };
struct BRowDirect { const bf16_t* Bt; int ldb; __device__ __forceinline__ const bf16_t* row(int n) const { return Bt + (size_t)n * ldb; } };
struct BRowGateUp { const bf16_t* Bt; int ldb;
    __device__ __forceinline__ const bf16_t* row(int n) const { const int tn = n >> 7, nl = n & 127, u = 64 * tn + 32 * (nl >> 6) + (nl & 31), nt = (nl >> 5) & 1;
        return Bt + (size_t)((u >> 7) * 256 + nt * 128 + (u & 127)) * ldb; } };

constexpr int GS = 72;
template <class AF, class BF, class Epi>
__device__ __forceinline__ void gemm_tile128(const AF& af, const BF& bf, int kbeg, int K, int m0, int n0, const Epi& epi, unsigned char* smem) {
    bf16_t* As = (bf16_t*)smem; bf16_t* Bs = As + 128 * GS;
    const int tid = opaque((int)threadIdx.x), lane = tid & 63, wv = tid >> 6, wm = wv & 3, wn = wv >> 2;
    const int r0 = tid >> 3, kc = (tid & 7) * 8 + kbeg;
    const bf16_t* bp0 = bf.row(n0 + r0) + kc; const bf16_t* bp1 = bf.row(n0 + r0 + 64) + kc;
    f32x16 acc0, acc1;
#pragma unroll
    for (int i = 0; i < 16; ++i) { acc0[i] = 0.f; acc1[i] = 0.f; }
    uint4 ra0 = *(const uint4*)af.ptr(m0 + r0, kc), ra1 = *(const uint4*)af.ptr(m0 + r0 + 64, kc), rb0 = *(const uint4*)bp0, rb1 = *(const uint4*)bp1;
    const int nk = K >> 6;
    const int aoff = (wm * 32 + (lane & 31)) * GS + (lane >> 5) * 8, boff = (wn * 64 + (lane & 31)) * GS + (lane >> 5) * 8;
    for (int kt = 0; kt < nk; ++kt) {
        __syncthreads();
        *(uint4*)(As + r0 * GS + (kc - kbeg)) = ra0; *(uint4*)(As + (r0 + 64) * GS + (kc - kbeg)) = ra1;
        *(uint4*)(Bs + r0 * GS + (kc - kbeg)) = rb0; *(uint4*)(Bs + (r0 + 64) * GS + (kc - kbeg)) = rb1;
        __syncthreads();
        if (kt + 1 < nk) { const int ko = (kt + 1) * 64; ra0 = *(const uint4*)af.ptr(m0 + r0, kc + ko); ra1 = *(const uint4*)af.ptr(m0 + r0 + 64, kc + ko); rb0 = *(const uint4*)(bp0 + ko); rb1 = *(const uint4*)(bp1 + ko); }
#pragma unroll
        for (int ks = 0; ks < 4; ++ks) {
            const bf16x8 a = *(const bf16x8*)(As + aoff + ks * 16);
            const bf16x8 b0 = *(const bf16x8*)(Bs + boff + ks * 16);
            const bf16x8 b1 = *(const bf16x8*)(Bs + boff + 32 * GS + ks * 16);
            acc0 = __builtin_amdgcn_mfma_f32_32x32x16_bf16(a, b0, acc0, 0, 0, 0);
            acc1 = __builtin_amdgcn_mfma_f32_32x32x16_bf16(a, b1, acc1, 0, 0, 0);
        }
    }
#pragma unroll
    for (int r = 0; r < 16; ++r) {
        const int row = m0 + wm * 32 + (r & 3) + 8 * (r >> 2) + 4 * (lane >> 5), col = n0 + wn * 64 + (lane & 31);
        epi(row, col, acc0[r], acc1[r]);
    }
    __syncthreads();
}

struct EpiProj { bf16_t* proj; float* small;
    __device__ __forceinline__ void st(int row, int col, float v) const { if (col < C_SMALL) proj[(size_t)row * PROJ_LD + col] = f2bf(v); else if (col < C_SMALL + 40) small[(size_t)row * 64 + (col - C_SMALL)] = v; }
    __device__ __forceinline__ void operator()(int row, int col, float v0, float v1) const { st(row, col, v0); st(row, col + 32, v1); } };
struct EpiHid { bf16_t* hid; const float* bias;
    __device__ __forceinline__ void operator()(int row, int col, float v0, float v1) const { hid[(size_t)row * 256 + col] = f2bf(silu_f(v0 + bias[col])); hid[(size_t)row * 256 + col + 32] = f2bf(silu_f(v1 + bias[col + 32])); } };
struct EpiKc { bf16_t* o;
    __device__ __forceinline__ void operator()(int row, int col, float v0, float v1) const { o[(size_t)row * 128 + col] = f2bf(v0); o[(size_t)row * 128 + col + 32] = f2bf(v1); } };
struct EpiOut { const float* x; const float* mod; float* x1;
    __device__ __forceinline__ void operator()(int row, int col, float v0, float v1) const { const float* g = mod + (row / T) * 12288 + 2 * 2048; const size_t o = (size_t)row * D + col;
        x1[o] = x[o] + g[col] * v0; x1[o + 32] = x[o + 32] + g[col + 32] * v1; } };
struct EpiAct { bf16_t* act; int rend;
    __device__ __forceinline__ void operator()(int row, int col, float v0, float v1) const { if (row < rend) { const int tn = col >> 7, nl = col & 127, u = 64 * tn + 32 * (nl >> 6) + (nl & 31);
        act[(size_t)row * EFF + u] = f2bf(silu_f(v0) * v1); } } };
struct EpiY { bf16_t* y; const float* roww; int rend;
    __device__ __forceinline__ void operator()(int row, int col, float v0, float v1) const { if (row < rend) { const float w = roww[row]; y[(size_t)row * D + col] = f2bf(v0 * w); y[(size_t)row * D + col + 32] = f2bf(v1 * w); } } };

template <class Epi>
__device__ __forceinline__ void phase_gemm_dense(const bf16_t* A, int lda, const bf16_t* Bt, int M, int N, int K, const Epi& epi, int bid, int nb, unsigned char* smem) {
    const int tm = M / 128, tn = N / 128;
    ARowDirect af{A, lda}; BRowDirect bf{Bt, K};
    for (int t = bid; t < tm * tn; t += nb) gemm_tile128(af, bf, 0, K, (t % tm) * 128, (t / tm) * 128, epi, smem);
}

constexpr int RAWS = 392, QS = 136, AS = 68;
__device__ __forceinline__ void phase_gdn_prep(const Params& p, int bid, int nb, unsigned char* smem) {
    bf16_t* raw = (bf16_t*)smem; float* sV = (float*)smem; float* sW = sV + 64 * 129;
    float* cw = (float*)(smem + 66048);
    bf16_t* sQ = (bf16_t*)(smem + 66048 + 6144); bf16_t* sK = sQ + 64 * QS;
    float* sA = (float*)(smem + 66048 + 6144 + 34816);
    float* s_beta = sA + 64 * AS; float* s_g = s_beta + 64; float* s_gc = s_g + 64; float* s_eg = s_gc + 64;
    const bf16_t* proj = (const bf16_t*)(p.ws + OFF_PROJ); const float* small = (const float*)(p.ws + OFF_SMALL);
    bf16_t* gnegw = (bf16_t*)(p.ws + OFF_GNEGW); bf16_t* gqd = (bf16_t*)(p.ws + OFF_GQD); bf16_t* gkdt = (bf16_t*)(p.ws + OFF_GKDT); bf16_t* gqk = (bf16_t*)(p.ws + OFF_GQK);
    bf16_t* gut = (bf16_t*)(p.ws + OFF_GUT2); float* egl = (float*)(p.ws + OFF_EGL);
    const int tid = opaque((int)threadIdx.x), lane = tid & 63, wv = tid >> 6;
    uint4 pre[7];
#define PREP_LOAD(jb) do { const int bh_ = (jb) >> 6, n_ = (jb) & 63, b_ = bh_ >> 3, h_ = bh_ & 7; \
        _Pragma("unroll") for (int i_ = 0; i_ < 7; ++i_) { const int id = tid + 512 * i_, r = id / 48, c = id - r * 48, tt = n_ * 64 - 3 + r; \
            pre[i_] = make_uint4(0u, 0u, 0u, 0u); \
            if (id < 67 * 48 && tt >= 0) pre[i_] = *(const uint4*)(proj + (size_t)(b_ * T + tt) * PROJ_LD + (c >> 4) * 1024 + h_ * 128 + (c & 15) * 8); } } while (0)
    if (bid < 1024) PREP_LOAD(bid);
    for (int job = bid; job < 1024; job += nb) {
        const int bh = job >> 6, n = job & 63, b = bh >> 3, h = bh & 7;
        const int row0 = b * T + n * 64;
#pragma unroll
        for (int i_ = 0; i_ < 7; ++i_) { const int id = tid + 512 * i_, r = id / 48, c = id - r * 48; if (id < 67 * 48) *(uint4*)(raw + r * RAWS + c * 8) = pre[i_]; }
        for (int id = tid; id < 4 * 384; id += NTHR) { const int i = id / 384, cc = id - i * 384; cw[id] = p.conv_w[i * 3072 + (cc >> 7) * 1024 + h * 128 + (cc & 127)]; }
        if (tid < 64) { const int row = row0 + tid; s_beta[tid] = sigmoid_f(small[(size_t)row * 64 + h]);
            s_g[tid] = -__expf(p.a_log[h]) * softplus_f(small[(size_t)row * 64 + 8 + h] + p.dt_bias[h]); }
        __syncthreads();
        if (tid == 0) { float s = 0.f; for (int t = 0; t < 64; ++t) { s += s_g[t]; s_gc[t] = s; } }
        float vkeep[2][8];
#pragma unroll
        for (int part = 0; part < 3; ++part)
#pragma unroll
            for (int it = 0; it < 2; ++it) {
                const int id = tid + 512 * it, ch = id & 15, t = id >> 4, cc = part * 128 + ch * 8;
                float acc[8];
#pragma unroll
                for (int q = 0; q < 8; ++q) acc[q] = 0.f;
#pragma unroll
                for (int i = 0; i < 4; ++i) { const uint4 rv = *(const uint4*)(raw + (t + i) * RAWS + cc); const f32x4 w0 = *(const f32x4*)(cw + i * 384 + cc), w1 = *(const f32x4*)(cw + i * 384 + cc + 4);
                    acc[0] += w0[0] * bf2f((bf16_t)(rv.x & 0xffff)); acc[1] += w0[1] * bf2f((bf16_t)(rv.x >> 16)); acc[2] += w0[2] * bf2f((bf16_t)(rv.y & 0xffff)); acc[3] += w0[3] * bf2f((bf16_t)(rv.y >> 16));
                    acc[4] += w1[0] * bf2f((bf16_t)(rv.z & 0xffff)); acc[5] += w1[1] * bf2f((bf16_t)(rv.z >> 16)); acc[6] += w1[2] * bf2f((bf16_t)(rv.w & 0xffff)); acc[7] += w1[3] * bf2f((bf16_t)(rv.w >> 16)); }
                float ss = 0.f;
#pragma unroll
                for (int q = 0; q < 8; ++q) { acc[q] = silu_f(acc[q]); ss += acc[q] * acc[q]; }
                if (part < 2) {
                    ss += __shfl_xor(ss, 1); ss += __shfl_xor(ss, 2); ss += __shfl_xor(ss, 4); ss += __shfl_xor(ss, 8);
                    const float rn = rsqrtf(ss + 1e-6f) * (part == 0 ? 0.08838834764831845f : 1.f);
                    uint4 o; o.x = pack2(acc[0] * rn, acc[1] * rn); o.y = pack2(acc[2] * rn, acc[3] * rn); o.z = pack2(acc[4] * rn, acc[5] * rn); o.w = pack2(acc[6] * rn, acc[7] * rn);
                    *(uint4*)((part == 0 ? sQ : sK) + t * QS + ch * 8) = o;
                } else {
#pragma unroll
                    for (int q = 0; q < 8; ++q) vkeep[it][q] = acc[q];
                }
            }
        __syncthreads();
        if (tid < 64) s_eg[tid] = __expf(s_gc[tid]);
#pragma unroll
        for (int it = 0; it < 2; ++it) { const int id = tid + 512 * it, ch = id & 15, t = id >> 4; const float bt = s_beta[t];
#pragma unroll
            for (int q = 0; q < 8; ++q) sV[t * 129 + ch * 8 + q] = vkeep[it][q] * bt; }
#pragma unroll
        for (int it = 0; it < 2; ++it) { const int id = tid + 512 * it, ch = id & 15, t = id >> 4; const float f = s_beta[t] * __expf(s_gc[t]);
            const uint4 kv = *(const uint4*)(sK + t * QS + ch * 8); float* wp = sW + t * 129 + ch * 8;
            wp[0] = bf2f((bf16_t)(kv.x & 0xffff)) * f; wp[1] = bf2f((bf16_t)(kv.x >> 16)) * f; wp[2] = bf2f((bf16_t)(kv.y & 0xffff)) * f; wp[3] = bf2f((bf16_t)(kv.y >> 16)) * f;
            wp[4] = bf2f((bf16_t)(kv.z & 0xffff)) * f; wp[5] = bf2f((bf16_t)(kv.z >> 16)) * f; wp[6] = bf2f((bf16_t)(kv.w & 0xffff)) * f; wp[7] = bf2f((bf16_t)(kv.w >> 16)) * f; }
        {
            const int lo_ = opaque(lane); const int prod = wv >> 2, ti = (wv >> 1) & 1, tj = wv & 1, kr = lo_ & 31, hh = lo_ >> 5;
            const bf16_t* X = prod ? sQ : sK;
            f32x16 acc;
#pragma unroll
            for (int r = 0; r < 16; ++r) acc[r] = 0.f;
#pragma unroll
            for (int s = 0; s < 8; ++s) { const bf16x8 av = *(const bf16x8*)(X + (32 * ti + kr) * QS + 16 * s + 8 * hh); const bf16x8 bv = *(const bf16x8*)(sK + (32 * tj + kr) * QS + 16 * s + 8 * hh);
                acc = MFMA32(av, bv, acc); }
            const int j = 32 * tj + kr; const float gcj = s_gc[j];
#pragma unroll
            for (int r = 0; r < 16; ++r) { const int i = 32 * ti + (r & 3) + 8 * (r >> 2) + 4 * hh;
                const float dec = (i >= j) ? __expf(s_gc[i] - gcj) : 0.f;
                if (prod == 0) sA[i * AS + j] = (i > j) ? s_beta[i] * acc[r] * dec : 0.f;
                else gqk[(size_t)job * 4096 + i * 64 + (j & 32) + perm32(j & 31)] = f2bf(acc[r] * dec); }
        }
        __syncthreads();
        if (job + nb < 1024) PREP_LOAD(job + nb);
        if (tid < 256) {
            float* colp = (tid < 128) ? (sV + tid) : (sW + (tid - 128));
            const float* sAo = sA + opaque(0);
            float x[64];
#pragma unroll
            for (int i = 0; i < 64; ++i) {
                float s = colp[i * 129];
#pragma unroll
                for (int j4 = 0; j4 < (i + 3) / 4; ++j4) { const f32x4 av = *(const f32x4*)(sAo + i * AS + 4 * j4);
#pragma unroll
                    for (int q = 0; q < 4; ++q) if (4 * j4 + q < i) s -= av[q] * x[4 * j4 + q]; }
                x[i] = s; colp[i * 129] = s;
                if ((i & 3) == 3) __builtin_amdgcn_sched_barrier(0);
            }
        }
        __syncthreads();
        const float glast = s_gc[63];
        if (tid < 256) {
            const int c = tid >> 2, s = tid & 3; unsigned o[16];
#pragma unroll
            for (int pp = 0; pp < 16; ++pp) { const int p0 = 2 * pp, j0 = p0 & 7, g0 = p0 >> 3, d0 = 16 * (j0 >> 2) + 4 * g0 + (j0 & 3);
                o[pp] = pack2(-sW[c * 129 + 32 * s + d0], -sW[c * 129 + 32 * s + d0 + 1]); }
            uint4* dp = (uint4*)(gnegw + (size_t)job * 8192 + c * 128 + 32 * s);
#pragma unroll
            for (int q = 0; q < 4; ++q) dp[q] = make_uint4(o[4 * q], o[4 * q + 1], o[4 * q + 2], o[4 * q + 3]);
        } else {
            const int t2 = tid - 256, c = t2 >> 2, s = t2 & 3; const float eg = s_eg[c]; unsigned o[16];
#pragma unroll
            for (int pp = 0; pp < 16; ++pp) { const int p0 = 2 * pp, j0 = p0 & 7, g0 = p0 >> 3, d0 = 16 * (j0 >> 2) + 4 * g0 + (j0 & 3);
                o[pp] = pack2(bf2f(sQ[c * QS + 32 * s + d0]) * eg, bf2f(sQ[c * QS + 32 * s + d0 + 1]) * eg); }
            uint4* dp = (uint4*)(gqd + (size_t)job * 8192 + c * 128 + 32 * s);
#pragma unroll
            for (int q = 0; q < 4; ++q) dp[q] = make_uint4(o[4 * q], o[4 * q + 1], o[4 * q + 2], o[4 * q + 3]);
        }
        if (tid < 256) {
            const int d = tid >> 1, s = tid & 1; unsigned o[16];
#pragma unroll
            for (int pp = 0; pp < 16; ++pp) { const int p0 = 2 * pp, j0 = p0 & 7, g0 = p0 >> 3, c0 = 32 * s + 16 * (j0 >> 2) + 4 * g0 + (j0 & 3);
                o[pp] = pack2(bf2f(sK[c0 * QS + d]) * __expf(glast - s_gc[c0]), bf2f(sK[(c0 + 1) * QS + d]) * __expf(glast - s_gc[c0 + 1])); }
            uint4* dp = (uint4*)(gkdt + (size_t)job * 8192 + d * 64 + 32 * s);
#pragma unroll
            for (int q = 0; q < 4; ++q) dp[q] = make_uint4(o[4 * q], o[4 * q + 1], o[4 * q + 2], o[4 * q + 3]);
        } else {
            const int t2 = tid - 256, d = t2 >> 1, s = t2 & 1; unsigned o[16];
#pragma unroll
            for (int pp = 0; pp < 16; ++pp) o[pp] = pack2(sV[(32 * s + 2 * pp) * 129 + d], sV[(32 * s + 2 * pp + 1) * 129 + d]);
            uint4* dp = (uint4*)(gut + (size_t)job * 8192 + d * 64 + 32 * s);
#pragma unroll
            for (int q = 0; q < 4; ++q) dp[q] = make_uint4(o[4 * q], o[4 * q + 1], o[4 * q + 2], o[4 * q + 3]);
        }
        if (tid == 0) egl[job] = __expf(glast);
        __syncthreads();
    }
#undef PREP_LOAD
}

constexpr int GW = 136, GK = 72, GO = 132;
constexpr int GU = 72;
constexpr int GSCAN_BUF = (64 * GW + 128 * GK + 128 * GU) * 2;
__device__ __forceinline__ void phase_gdn_scan(const Params& p, int bh, unsigned char* smem) {
    const bf16_t* gnegw = (const bf16_t*)(p.ws + OFF_GNEGW); const bf16_t* gkdt = (const bf16_t*)(p.ws + OFF_GKDT);
    const bf16_t* gut = (const bf16_t*)(p.ws + OFF_GUT2); const float* egl = (const float*)(p.ws + OFF_EGL);
    uint4* gsb = (uint4*)(p.ws + OFF_GSB); uint4* gvb = (uint4*)(p.ws + OFF_GVB);
    const int tid = opaque((int)threadIdx.x), lane = tid & 63, wv = tid >> 6, g = lane >> 4, c16 = lane & 15, e = wv * 16 + c16;
    const int r1 = tid >> 4, k1 = (tid & 15) * 8;
    const int r2 = tid >> 3, k2 = (tid & 7) * 8;
    uint4 Aw0, Aw1, Ak0, Ak1, Au0, Au1, Bw0, Bw1, Bk0, Bk1, Bu0, Bu1;
#define GDN_LOAD(X, job) do { const size_t o_ = (size_t)(job) * 8192; \
        X##w0 = *(const uint4*)(gnegw + o_ + r1 * 128 + k1); X##w1 = *(const uint4*)(gnegw + o_ + (r1 + 32) * 128 + k1); \
        X##k0 = *(const uint4*)(gkdt + o_ + r2 * 64 + k2); X##k1 = *(const uint4*)(gkdt + o_ + (r2 + 64) * 64 + k2); \
        X##u0 = *(const uint4*)(gut + o_ + r2 * 64 + k2); X##u1 = *(const uint4*)(gut + o_ + (r2 + 64) * 64 + k2); } while (0)
#define GDN_STORE(X, bufi) do { bf16_t* sWn_ = (bf16_t*)(smem + (bufi) * GSCAN_BUF); bf16_t* sKd_ = sWn_ + 64 * GW; bf16_t* sU_ = sKd_ + 128 * GK; \
        *(uint4*)(sWn_ + r1 * GW + k1) = X##w0; *(uint4*)(sWn_ + (r1 + 32) * GW + k1) = X##w1; \
        *(uint4*)(sKd_ + r2 * GK + k2) = X##k0; *(uint4*)(sKd_ + (r2 + 64) * GK + k2) = X##k1; \
        *(uint4*)(sU_ + r2 * GU + k2) = X##u0; *(uint4*)(sU_ + (r2 + 64) * GU + k2) = X##u1; } while (0)
    f32x4 S[8];
#pragma unroll
    for (int i = 0; i < 8; ++i) S[i] = (f32x4){0.f, 0.f, 0.f, 0.f};
    GDN_LOAD(A, bh * 64);
    GDN_STORE(A, 0);
    GDN_LOAD(B, bh * 64 + 1); GDN_LOAD(A, bh * 64 + 2);
    __syncthreads();
#define GDN_STEP(n, X) do { \
        const int job = bh * 64 + (n); \
        if ((n) + 1 < 64) { GDN_STORE(X, ((n) + 1) & 1); if ((n) + 3 < 64) GDN_LOAD(X, job + 3); } \
        const bf16_t* sWn = (const bf16_t*)(smem + ((n) & 1) * GSCAN_BUF); const bf16_t* sKd = sWn + 64 * GW; const bf16_t* sU = sKd + 128 * GK; \
        f32x4 vacc[4]; \
        _Pragma("unroll") for (int ct = 0; ct < 4; ++ct) { const uint2 uu = *(const uint2*)(sU + e * GU + 16 * ct + 4 * g); \
            vacc[ct] = (f32x4){bf2f((bf16_t)(uu.x & 0xffff)), bf2f((bf16_t)(uu.x >> 16)), bf2f((bf16_t)(uu.y & 0xffff)), bf2f((bf16_t)(uu.y >> 16))}; } \
        const float eg = egl[job]; \
        bf16x8 sB[4]; \
        _Pragma("unroll") for (int s = 0; s < 4; ++s) { const uint4 tq = make_uint4(pack2(S[2 * s][0], S[2 * s][1]), pack2(S[2 * s][2], S[2 * s][3]), \
            pack2(S[2 * s + 1][0], S[2 * s + 1][1]), pack2(S[2 * s + 1][2], S[2 * s + 1][3])); sB[s] = __builtin_bit_cast(bf16x8, tq); \
            gsb[((size_t)(job * 8 + wv) * 4 + s) * 64 + lane] = tq; } \
        _Pragma("unroll") for (int ct = 0; ct < 4; ++ct) _Pragma("unroll") for (int s = 0; s < 4; ++s) { \
                const bf16x8 aw = *(const bf16x8*)(sWn + (16 * ct + c16) * GW + 32 * s + 8 * g); \
                vacc[ct] = __builtin_amdgcn_mfma_f32_16x16x32_bf16(aw, sB[s], vacc[ct], 0, 0, 0); } \
        bf16x8 vB[2]; \
        _Pragma("unroll") for (int s = 0; s < 2; ++s) { const uint4 tq = make_uint4(pack2(vacc[2 * s][0], vacc[2 * s][1]), pack2(vacc[2 * s][2], vacc[2 * s][3]), \
            pack2(vacc[2 * s + 1][0], vacc[2 * s + 1][1]), pack2(vacc[2 * s + 1][2], vacc[2 * s + 1][3])); vB[s] = __builtin_bit_cast(bf16x8, tq); \
            gvb[((size_t)(job * 8 + wv) * 2 + s) * 64 + lane] = tq; } \
        _Pragma("unroll") for (int dt = 0; dt < 8; ++dt) { S[dt] *= eg; \
            _Pragma("unroll") for (int s = 0; s < 2; ++s) { \
                const bf16x8 a = *(const bf16x8*)(sKd + (16 * dt + c16) * GK + 32 * s + 8 * g); \
                S[dt] = __builtin_amdgcn_mfma_f32_16x16x32_bf16(a, vB[s], S[dt], 0, 0, 0); } } \
        LDS_BARRIER(); \
    } while (0)
    for (int n = 0; n < 64; n += 2) { GDN_STEP(n, B); GDN_STEP(n + 1, A); }
#undef GDN_LOAD
#undef GDN_STORE
#undef GDN_STEP
}

__device__ __forceinline__ void phase_gdn_out(const Params& p, int bid, int nb, unsigned char* smem) {
    bf16_t* sQd = (bf16_t*)smem; bf16_t* sQK = sQd + 64 * GW; bf16_t* sG = sQK + 64 * GK; float* sO = (float*)(sG + 64 * GW); float* sNW = sO + 64 * GO;
    const bf16_t* proj = (const bf16_t*)(p.ws + OFF_PROJ); const bf16_t* gqd = (const bf16_t*)(p.ws + OFF_GQD); const bf16_t* gqk = (const bf16_t*)(p.ws + OFF_GQK);
    const uint4* gsb = (const uint4*)(p.ws + OFF_GSB); const uint4* gvb = (const uint4*)(p.ws + OFF_GVB);
    bf16_t* ycat = (bf16_t*)(p.ws + OFF_YCAT);
    const int tid = opaque((int)threadIdx.x), lane = tid & 63, wv = tid >> 6, g = lane >> 4, c16 = lane & 15, e = wv * 16 + c16;
    const int r1 = tid >> 4, k1 = (tid & 15) * 8, r2 = tid >> 3, k2 = (tid & 7) * 8, ec = tid >> 3, ee = (tid & 7) * 16;
    if (tid < 128) sNW[tid] = p.gdn_norm_w[tid];
    for (int job = bid; job < 1024; job += nb) {
        const int bh = job >> 6, n = job & 63, b = bh >> 3, h = bh & 7;
        const size_t o_ = (size_t)job * 8192; const bf16_t* gp_ = proj + (size_t)(b * T + n * 64) * PROJ_LD + C_GATEG + h * 128;
        const uint4 q0 = *(const uint4*)(gqd + o_ + r1 * 128 + k1), q1 = *(const uint4*)(gqd + o_ + (r1 + 32) * 128 + k1), qk = *(const uint4*)(gqk + (size_t)job * 4096 + r2 * 64 + k2);
        const uint4 g0 = *(const uint4*)(gp_ + (size_t)r1 * PROJ_LD + k1), g1 = *(const uint4*)(gp_ + (size_t)(r1 + 32) * PROJ_LD + k1);
        bf16x8 sB[4], vB[2];
#pragma unroll
        for (int s = 0; s < 4; ++s) { const uint4 tq = gsb[((size_t)(job * 8 + wv) * 4 + s) * 64 + lane]; sB[s] = __builtin_bit_cast(bf16x8, tq); }
#pragma unroll
        for (int s = 0; s < 2; ++s) { const uint4 tq = gvb[((size_t)(job * 8 + wv) * 2 + s) * 64 + lane]; vB[s] = __builtin_bit_cast(bf16x8, tq); }
        __syncthreads();
        *(uint4*)(sQd + r1 * GW + k1) = q0; *(uint4*)(sQd + (r1 + 32) * GW + k1) = q1; *(uint4*)(sQK + r2 * GK + k2) = qk;
        *(uint4*)(sG + r1 * GW + k1) = g0; *(uint4*)(sG + (r1 + 32) * GW + k1) = g1;
        __syncthreads();
        f32x4 oacc[4];
#pragma unroll
        for (int ct = 0; ct < 4; ++ct) { oacc[ct] = (f32x4){0.f, 0.f, 0.f, 0.f};
#pragma unroll
            for (int s = 0; s < 4; ++s) { const bf16x8 aq = *(const bf16x8*)(sQd + (16 * ct + c16) * GW + 32 * s + 8 * g); oacc[ct] = __builtin_amdgcn_mfma_f32_16x16x32_bf16(aq, sB[s], oacc[ct], 0, 0, 0); }
#pragma unroll
            for (int s = 0; s < 2; ++s) { const bf16x8 a = *(const bf16x8*)(sQK + (16 * ct + c16) * GK + 32 * s + 8 * g); oacc[ct] = __builtin_amdgcn_mfma_f32_16x16x32_bf16(a, vB[s], oacc[ct], 0, 0, 0); } }
#pragma unroll
        for (int ct = 0; ct < 4; ++ct)
#pragma unroll
            for (int i = 0; i < 4; ++i) sO[(16 * ct + 4 * g + i) * GO + e] = oacc[ct][i];
        __syncthreads();
        {
            f32x4 o[4]; float ss = 0.f;
#pragma unroll
            for (int q = 0; q < 4; ++q) { o[q] = *(const f32x4*)(sO + ec * GO + ee + 4 * q); ss += o[q][0] * o[q][0] + o[q][1] * o[q][1] + o[q][2] * o[q][2] + o[q][3] * o[q][3]; }
            ss += __shfl_xor(ss, 1); ss += __shfl_xor(ss, 2); ss += __shfl_xor(ss, 4);
            const float rstd = rsqrtf(ss * (1.f / 128.f) + 1e-6f);
            const uint4 gq0 = *(const uint4*)(sG + ec * GW + ee), gq1 = *(const uint4*)(sG + ec * GW + ee + 8);
            unsigned yo[8];
#pragma unroll
            for (int q = 0; q < 8; ++q) { const unsigned gwq = (q == 0) ? gq0.x : (q == 1) ? gq0.y : (q == 2) ? gq0.z : (q == 3) ? gq0.w : (q == 4) ? gq1.x : (q == 5) ? gq1.y : (q == 6) ? gq1.z : gq1.w;
                const float ga = bf2f((bf16_t)(gwq & 0xffff)), gb = bf2f((bf16_t)(gwq >> 16)); const f32x4 nwv = *(const f32x4*)(sNW + ee + 4 * (q >> 1));
                const float y0 = o[q >> 1][(q & 1) * 2] * rstd * nwv[(q & 1) * 2] * silu_f(ga), y1 = o[q >> 1][(q & 1) * 2 + 1] * rstd * nwv[(q & 1) * 2 + 1] * silu_f(gb);
                yo[q] = pack2(y0, y1); }
            uint4* yp = (uint4*)(ycat + (size_t)(b * T + n * 64 + ec) * D + h * 128 + ee);
            yp[0] = make_uint4(yo[0], yo[1], yo[2], yo[3]); yp[1] = make_uint4(yo[4], yo[5], yo[6], yo[7]);
        }
    }
    __syncthreads();
}

constexpr int OS = 136;
constexpr int NSA_KV = 16384;
constexpr float NSA_SC2 = 0.08838834764831845f * 1.4426950408889634f;
typedef short s16x4 __attribute__((ext_vector_type(4)));

__device__ __forceinline__ void nsa_stage(const bf16_t* Kg, const bf16_t* Vg, int ld, unsigned char* smem, int buf) {
    const int tid = opaque((int)threadIdx.x), L = tid & 63, wvu = __builtin_amdgcn_readfirstlane(tid >> 6);
#pragma unroll
    for (int i = 0; i < 2; ++i) {
        const int row = 8 * wvu + 4 * i + (L >> 4), pos = L & 15, ch = pos ^ (((row & 3) << 2) | ((row >> 2) & 3));
        const size_t go = (size_t)row * ld + ch * 8;
        __builtin_amdgcn_global_load_lds((const unsigned*)(Kg + go), (LAS unsigned*)(smem + buf + wvu * 2048 + i * 1024), 16, 0, 0);
        __builtin_amdgcn_global_load_lds((const unsigned*)(Vg + go), (LAS unsigned*)(smem + buf + NSA_KV + wvu * 2048 + i * 1024), 16, 0, 0);
    }
}
__device__ __forceinline__ void nsa_scores(const unsigned char* sK, const bf16x8 (&bq)[8], f32x16& s0, f32x16& s1, int lane) {
    lane = opaque(lane); const int kr = lane & 31, h = lane >> 5, xr = ((kr & 3) << 2) | ((kr >> 2) & 3);
    const unsigned char* rp = sK + 256 * kr;
#pragma unroll
    for (int i = 0; i < 16; ++i) { s0[i] = 0.f; s1[i] = 0.f; }
#pragma unroll
    for (int s = 0; s < 8; ++s) {
        const int o = 16 * ((2 * s + h) ^ xr);
        const bf16x8 a0 = *(const bf16x8*)(rp + o);
        const bf16x8 a1 = *(const bf16x8*)(rp + 8192 + o);
        s0 = MFMA32(a0, bq[s], s0); s1 = MFMA32(a1, bq[s], s1);
        if (s & 1) __builtin_amdgcn_sched_barrier(0);
    }
}
__device__ __forceinline__ void nsa_pv_sel(const unsigned char* sV, const f32x16& p0, const f32x16& p1, f32x16 (&oacc)[4], unsigned pmask, int lane) {
    lane = opaque(lane); const int h = lane >> 5, blk = (lane >> 4) & 1, q = (lane & 15) >> 2, pp = lane & 3;
    const int base = 1024 * h + 256 * q + 8 * (pp & 1), lowv = 2 * blk + (pp >> 1);
#pragma unroll
    for (int s = 0; s < 4; ++s) { union { bf16x8 v; unsigned u[4]; } t;
#pragma unroll
        for (int j = 0; j < 4; ++j) { const int r = 8 * (s & 1) + 2 * j; t.u[j] = ((s < 2) ? pack2(p0[r], p0[r + 1]) : pack2(p1[r], p1[r + 1])) & pmask; }
#pragma unroll
        for (int dt = 0; dt < 4; ++dt) {
            union { bf16x8 v; s16x4 hlf[2]; } a;
#pragma unroll
            for (int tt = 0; tt < 2; ++tt) { const int ad = base + 4096 * s + 2048 * tt + 64 * (dt ^ q) + 16 * (lowv ^ (2 * tt + h));
                a.hlf[tt] = __builtin_amdgcn_ds_read_tr16_b64_v4i16((LAS s16x4*)(sV + ad)); }
            oacc[dt] = MFMA32(a.v, t.v, oacc[dt]);
        }
        __builtin_amdgcn_sched_barrier(0); }
}
__device__ __forceinline__ void nsa_pv(const unsigned char* sV, const f32x16& p0, const f32x16& p1, f32x16 (&oacc)[4], int lane) { nsa_pv_sel(sV, p0, p1, oacc, 0xffffffffu, lane); }
template <class VF>
__device__ __forceinline__ void nsa_tile_online(const unsigned char* sK, const unsigned char* sV, const bf16x8 (&bq)[8], f32x16 (&oacc)[4], float& m, float& l, const VF& valid, int lane) {
    const int h = opaque(lane) >> 5;
    f32x16 s0, s1;
    nsa_scores(sK, bq, s0, s1, lane);
    float mx = -1e30f;
#pragma unroll
    for (int r = 0; r < 16; ++r) { const int key = (r & 3) + 8 * (r >> 2) + 4 * h;
        s0[r] = valid(key) ? s0[r] * NSA_SC2 : -1e30f; s1[r] = valid(key + 32) ? s1[r] * NSA_SC2 : -1e30f;
        mx = fmaxf(mx, fmaxf(s0[r], s1[r])); }
    mx = fmaxf(mx, __shfl_xor(mx, 32));
    const float mn = fmaxf(m, mx);
    const float alpha = __builtin_amdgcn_exp2f(m - mn);
    float ps = 0.f;
#pragma unroll
    for (int r = 0; r < 16; ++r) {
        s0[r] = (s0[r] > -1e29f) ? __builtin_amdgcn_exp2f(s0[r] - mn) : 0.f;
        s1[r] = (s1[r] > -1e29f) ? __builtin_amdgcn_exp2f(s1[r] - mn) : 0.f;
        ps += s0[r] + s1[r]; }
    l = l * alpha + ps; m = mn;
#pragma unroll
    for (int dt = 0; dt < 4; ++dt)
#pragma unroll
        for (int r = 0; r < 16; ++r) oacc[dt][r] *= alpha;
    nsa_pv(sV, s0, s1, oacc, lane);
}
__device__ __forceinline__ void nsa_tile_fast(const unsigned char* sK, const unsigned char* sV, const bf16x8 (&bq)[8], f32x16 (&oacc)[4], float& m, float& l, bool rowsel, int lane) {
    f32x16 s0, s1;
    nsa_scores(sK, bq, s0, s1, lane);
    float mx = fmaxf(s0[0], s1[0]);
#pragma unroll
    for (int r = 1; r < 16; ++r) mx = fmaxf(mx, fmaxf(s0[r], s1[r]));
    mx = fmaxf(mx, __shfl_xor(mx, 32)) * NSA_SC2;
    if (__any(mx > m + 8.f)) {
        const float mn = (mx > m + 8.f) ? mx : m;
        const float alpha = __builtin_amdgcn_exp2f(m - mn);
        m = mn; l *= alpha;
#pragma unroll
        for (int dt = 0; dt < 4; ++dt)
#pragma unroll
            for (int r = 0; r < 16; ++r) oacc[dt][r] *= alpha;
    }
    float ps = 0.f;
#pragma unroll
    for (int r = 0; r < 16; ++r) { s0[r] = __builtin_amdgcn_exp2f(fmaf(s0[r], NSA_SC2, -m)); s1[r] = __builtin_amdgcn_exp2f(fmaf(s1[r], NSA_SC2, -m)); ps += s0[r] + s1[r]; }
    l += rowsel ? ps : 0.f;
    nsa_pv_sel(sV, s0, s1, oacc, rowsel ? 0xffffffffu : 0u, lane);
}
__device__ __forceinline__ void nsa_flush(bf16_t* yrow, const f32x16 (&oacc)[4], float f, bool first, int lane) {
    const int h = opaque(lane) >> 5;
#pragma unroll
    for (int dt = 0; dt < 4; ++dt)
#pragma unroll
        for (int rr = 0; rr < 4; ++rr) {
            bf16_t* dp = yrow + 32 * dt + 8 * rr + 4 * h;
            float v[4];
#pragma unroll
            for (int i = 0; i < 4; ++i) v[i] = oacc[dt][4 * rr + i] * f;
            if (!first) { const uint2 o = *(const uint2*)dp; v[0] += bf2f((bf16_t)(o.x & 0xffff)); v[1] += bf2f((bf16_t)(o.x >> 16)); v[2] += bf2f((bf16_t)(o.y & 0xffff)); v[3] += bf2f((bf16_t)(o.y >> 16)); }
            uint2 o; o.x = pack2(v[0], v[1]); o.y = pack2(v[2], v[3]); *(uint2*)dp = o;
        }
}

constexpr int NSA_BUF = 2 * NSA_KV;
#define NSA_WAIT(ahead) do { if ((ahead) >= 2) asm volatile("s_waitcnt vmcnt(8)" ::: "memory"); else if ((ahead) == 1) asm volatile("s_waitcnt vmcnt(4)" ::: "memory"); \
        else asm volatile("s_waitcnt vmcnt(0)" ::: "memory"); LDS_BARRIER(); } while (0)

__device__ __forceinline__ void nsa_job(const Params& p, int job, unsigned char* smem) {
    float* sImp = (float*)(smem + 4 * NSA_BUF); unsigned* sMask = (unsigned*)(sImp + 64 * 64);
    const bf16_t* proj = (const bf16_t*)(p.ws + OFF_PROJ); const float* small = (const float*)(p.ws + OFF_SMALL);
    const bf16_t* kc = (const bf16_t*)(p.ws + OFF_KVC); const bf16_t* vc = kc + 1024 * 128;
    const int tid = opaque((int)threadIdx.x), lane = tid & 63, wv = tid >> 6, h = lane >> 5, ql = lane & 31, tl = ql >> 2, gh = ql & 3;
    const int b = job >> 7, kvh = (job >> 6) & 1, qt = job & 63, t0 = qt * 64;
    const int tq = t0 + 8 * wv + tl;
    const size_t qrow = (size_t)(b * T + tq);
    const int head = kvh * 4 + gh;
    bf16_t* yrow = (bf16_t*)(p.ws + OFF_YCAT) + qrow * D + 1024 + head * 128;
    const int nct = (((t0 + 32) >> 4) >> 6) + 1;
    const bf16_t* kcb = kc + (size_t)(b * 512 + kvh * 256) * 128; const bf16_t* vcb = vc + (size_t)(b * 512 + kvh * 256) * 128;
    const bf16_t* pb = proj + (size_t)(b * T) * PROJ_LD + kvh * 128;
    const int jw0 = qt > 8 ? qt - 8 : 0;
    int nis, ncomp;
    __syncthreads();
    bf16x8 bq[8];
#pragma unroll
    for (int s = 0; s < 8; ++s) bq[s] = *(const bf16x8*)(proj + qrow * PROJ_LD + C_QN + head * 128 + 16 * s + 8 * h);
    f32x16 oacc[4];
    float m = -1e30f, l = 0.f;
    nis = 0; ncomp = 0;
    for (; nis < 3 && nis < nct; ++nis) nsa_stage(kcb + (size_t)nis * 64 * 128, vcb + (size_t)nis * 64 * 128, 128, smem, (nis & 3) * NSA_BUF);
    for (int ct = 0; ct < nct; ++ct) {
        NSA_WAIT(nis - ncomp - 1);
        const unsigned char* sK = smem + (ncomp & 3) * NSA_BUF; ++ncomp;
        if (nis < nct) { nsa_stage(kcb + (size_t)nis * 64 * 128, vcb + (size_t)nis * 64 * 128, 128, smem, (nis & 3) * NSA_BUF); ++nis; }
        f32x16 s0, s1; nsa_scores(sK, bq, s0, s1, lane);
        float mx = -1e30f; const int hh = opaque(lane) >> 5;
#pragma unroll
        for (int r = 0; r < 16; ++r) { const int c = ct * 64 + (r & 3) + 8 * (r >> 2) + 4 * hh;
            s0[r] = (c * 16 + 31 <= tq) ? s0[r] * NSA_SC2 : -1e30f; s1[r] = ((c + 32) * 16 + 31 <= tq) ? s1[r] * NSA_SC2 : -1e30f; mx = fmaxf(mx, fmaxf(s0[r], s1[r])); }
        mx = fmaxf(mx, __shfl_xor(mx, 32));
        const float mn = fmaxf(m, mx); float ps = 0.f;
#pragma unroll
        for (int r = 0; r < 16; ++r) { ps += (s0[r] > -1e29f) ? __builtin_amdgcn_exp2f(s0[r] - mn) : 0.f; ps += (s1[r] > -1e29f) ? __builtin_amdgcn_exp2f(s1[r] - mn) : 0.f; }
        l = l * __builtin_amdgcn_exp2f(m - mn) + ps; m = mn;
    }
    l += __shfl_xor(l, 32);
    const float linv = l > 0.f ? 1.f / l : 0.f;
#pragma unroll
    for (int dt = 0; dt < 4; ++dt)
#pragma unroll
        for (int r = 0; r < 16; ++r) oacc[dt][r] = 0.f;
    float carry = 0.f;
    LDS_BARRIER();
    nis = 0; ncomp = 0;
    for (; nis < 3 && nis < nct; ++nis) nsa_stage(kcb + (size_t)nis * 64 * 128, vcb + (size_t)nis * 64 * 128, 128, smem, (nis & 3) * NSA_BUF);
    for (int ct = 0; ct < 4; ++ct) {
        if (ct < nct) {
            NSA_WAIT(nis - ncomp - 1);
            const unsigned char* sK = smem + (ncomp & 3) * NSA_BUF; ++ncomp;
            if (nis < nct) { nsa_stage(kcb + (size_t)nis * 64 * 128, vcb + (size_t)nis * 64 * 128, 128, smem, (nis & 3) * NSA_BUF); ++nis; }
            f32x16 s0, s1; nsa_scores(sK, bq, s0, s1, lane); const int hh = opaque(lane) >> 5;
#pragma unroll
            for (int r = 0; r < 16; ++r) { const int c = ct * 64 + (r & 3) + 8 * (r >> 2) + 4 * hh;
                s0[r] = (c * 16 + 31 <= tq) ? __builtin_amdgcn_exp2f(s0[r] * NSA_SC2 - m) * linv : 0.f;
                s1[r] = ((c + 32) * 16 + 31 <= tq) ? __builtin_amdgcn_exp2f(s1[r] * NSA_SC2 - m) * linv : 0.f; }
#pragma unroll
            for (int mt = 0; mt < 2; ++mt)
#pragma unroll
                for (int rr = 0; rr < 4; ++rr) {
                    const float G = (mt ? s1[4 * rr] : s0[4 * rr]) + (mt ? s1[4 * rr + 1] : s0[4 * rr + 1]) + (mt ? s1[4 * rr + 2] : s0[4 * rr + 2]) + (mt ? s1[4 * rr + 3] : s0[4 * rr + 3]);
                    const float mine_last = mt ? s1[4 * rr + 3] : s0[4 * rr + 3];
                    const float prev_last = (rr > 0) ? (mt ? s1[4 * rr - 1] : s0[4 * rr - 1]) : (mt ? s0[15] : carry);
                    const float send = h ? prev_last : mine_last;
                    float v = G + __shfl_xor(send, 32);
                    v += __shfl_xor(v, 1); v += __shfl_xor(v, 2);
                    if (gh == 0) sImp[(wv * 8 + tl) * 64 + 16 * ct + 8 * mt + 2 * rr + h] = v;
                }
            carry = s1[15];
            nsa_pv(sK + NSA_KV, s0, s1, oacc, lane);
        } else {
            if (gh == 0) {
#pragma unroll
                for (int q = 0; q < 8; ++q) sImp[(wv * 8 + tl) * 64 + 16 * ct + 2 * q + h] = 0.f;
            }
        }
    }
    LDS_BARRIER();
    nis = 0; ncomp = 0;
    { int wi = jw0; for (; nis < 3 && wi <= qt; ++nis, ++wi) nsa_stage(pb + (size_t)(wi * 64) * PROJ_LD + C_KWIN, pb + (size_t)(wi * 64) * PROJ_LD + C_VWIN, PROJ_LD, smem, (nis & 3) * NSA_BUF); }
    nsa_flush(yrow, oacc, sigmoid_f(small[qrow * 64 + 16 + head]), true, lane);
    {
        const int lo_ = opaque(lane); const int tk = lo_ >> 3, sub = lo_ & 7;
        unsigned lo = 0u, hi = 0u;
        if (qt < 16) { lo = (1u << (qt + 1)) - 1u; }
        else {
            const float* ip = sImp + (wv * 8 + tk) * 64;
            unsigned bits = 0u;
            for (int i = 0; i < 8; ++i) { const int j = sub * 8 + i; const float v = ip[j]; int rank = 0;
                for (int j2 = 1; j2 <= qt - 2; ++j2) { const float v2 = ip[j2]; rank += (v2 > v || (v2 == v && j2 < j)) ? 1 : 0; }
                if (j >= 1 && j <= qt - 2 && rank < 13) bits |= 1u << i; }
            if (sub < 4) lo = bits << (8 * sub); else hi = bits << (8 * (sub - 4));
            lo |= __shfl_xor(lo, 1); hi |= __shfl_xor(hi, 1); lo |= __shfl_xor(lo, 2); hi |= __shfl_xor(hi, 2); lo |= __shfl_xor(lo, 4); hi |= __shfl_xor(hi, 4);
            lo |= 1u;
            if (qt < 32) lo |= 1u << qt; else hi |= 1u << (qt - 32);
            if (qt - 1 < 32) lo |= 1u << (qt - 1); else hi |= 1u << (qt - 33);
        }
        if (sub == 0) { sMask[(wv * 8 + tk) * 2] = lo; sMask[(wv * 8 + tk) * 2 + 1] = hi; }
    }
    LDS_BARRIER();
    const unsigned long long mymask = (unsigned long long)sMask[(wv * 8 + tl) * 2] | ((unsigned long long)sMask[(wv * 8 + tl) * 2 + 1] << 32);
    unsigned long long un;
    { unsigned lo = sMask[lane * 2], hi = sMask[lane * 2 + 1];
#pragma unroll
      for (int o = 32; o > 0; o >>= 1) { lo |= __shfl_xor(lo, o); hi |= __shfl_xor(hi, o); }
      un = (unsigned long long)(unsigned)__builtin_amdgcn_readfirstlane((int)lo) | ((unsigned long long)(unsigned)__builtin_amdgcn_readfirstlane((int)hi) << 32); }
#pragma unroll
    for (int dt = 0; dt < 4; ++dt)
#pragma unroll
        for (int r = 0; r < 16; ++r) oacc[dt][r] = 0.f;
    m = -1e30f; l = 0.f;
    {
        int wi = jw0 + nis;
        for (int j = jw0; j <= qt; ++j) {
            NSA_WAIT(nis - ncomp - 1);
            const unsigned char* sK = smem + (ncomp & 3) * NSA_BUF; ++ncomp;
            if (wi <= qt) { nsa_stage(pb + (size_t)(wi * 64) * PROJ_LD + C_KWIN, pb + (size_t)(wi * 64) * PROJ_LD + C_VWIN, PROJ_LD, smem, (nis & 3) * NSA_BUF); ++nis; ++wi; }
            const int kbase = j * 64;
            if (j < qt && j >= qt - 7) nsa_tile_fast(sK, sK + NSA_KV, bq, oacc, m, l, true, lane);
            else nsa_tile_online(sK, sK + NSA_KV, bq, oacc, m, l, [&](int key) { const int kp = kbase + key; return kp <= tq && kp > tq - 512; }, lane);
        }
    }
    LDS_BARRIER();
    nis = 0; ncomp = 0;
    unsigned long long irem = un >> 1; int ij = 0; bool imore = true;
    for (; nis < 3 && imore; ++nis) {
        nsa_stage(pb + (size_t)(ij * 64) * PROJ_LD + C_KSLC, pb + (size_t)(ij * 64) * PROJ_LD + C_VSLC, PROJ_LD, smem, (nis & 3) * NSA_BUF);
        if (irem == 0ull) imore = false; else { const int z = __builtin_ctzll(irem); ij += 1 + z; irem = (z >= 63) ? 0ull : (irem >> (z + 1)); } }
    { const float lt = l + __shfl_xor(l, 32); nsa_flush(yrow, oacc, lt > 0.f ? sigmoid_f(small[qrow * 64 + 32 + head]) / lt : 0.f, false, lane); }
#pragma unroll
    for (int dt = 0; dt < 4; ++dt)
#pragma unroll
        for (int r = 0; r < 16; ++r) oacc[dt][r] = 0.f;
    m = -1e30f; l = 0.f;
    {
        unsigned long long rem = un >> 1; int j = 0;
        for (;;) {
            NSA_WAIT(nis - ncomp - 1);
            const unsigned char* sK = smem + (ncomp & 3) * NSA_BUF; ++ncomp;
            if (imore) { nsa_stage(pb + (size_t)(ij * 64) * PROJ_LD + C_KSLC, pb + (size_t)(ij * 64) * PROJ_LD + C_VSLC, PROJ_LD, smem, (nis & 3) * NSA_BUF); ++nis;
                if (irem == 0ull) imore = false; else { const int z = __builtin_ctzll(irem); ij += 1 + z; irem = (z >= 63) ? 0ull : (irem >> (z + 1)); } }
            const bool selj = (mymask >> j) & 1ull; const int kbase = j * 64;
            if (j < qt) nsa_tile_fast(sK, sK + NSA_KV, bq, oacc, m, l, selj, lane);
            else nsa_tile_online(sK, sK + NSA_KV, bq, oacc, m, l, [&](int key) { return selj && (kbase + key <= tq); }, lane);
            if (rem == 0ull) break;
            const int z = __builtin_ctzll(rem); j += 1 + z; rem = (z >= 63) ? 0ull : (rem >> (z + 1));
        }
    }
    { const float lt = l + __shfl_xor(l, 32); nsa_flush(yrow, oacc, lt > 0.f ? sigmoid_f(small[qrow * 64 + 24 + head]) / lt : 0.f, false, lane); }
}

constexpr size_t OFF_CPART = OFF_FLAT;
struct EpiPart { float* o; __device__ __forceinline__ void operator()(int row, int col, float v0, float v1) const { o[(size_t)row * 256 + col] = v0; o[(size_t)row * 256 + col + 32] = v1; } };
__device__ __forceinline__ void phase_cmp1(const Params& p, int bid, int nb, unsigned char* smem) {
    for (int j = bid; j < 256; j += nb) {
        const int ks = j & 7, nt = (j >> 3) & 1, mt = (j >> 4) & 7, which = j >> 7;
        ARowWin af{(const bf16_t*)(p.ws + OFF_PROJ), which ? C_VCMP : C_KCMP}; BRowDirect bf{(const bf16_t*)(p.ws + OFF_W1T) + (size_t)which * 256 * 4096, 4096};
        EpiPart e{(float*)(p.ws + OFF_CPART) + (size_t)(ks * 2 + which) * 1024 * 256};
        gemm_tile128(af, bf, ks * 512, 512, mt * 128, nt * 128, e, smem);
    }
}
constexpr int HS = 264;
__device__ __forceinline__ void phase_cmp2(const Params& p, int bid, int nb, unsigned char* smem) {
    bf16_t* sH = (bf16_t*)smem;
    const int tid = opaque((int)threadIdx.x), lane = tid & 63, wv = tid >> 6;
    for (int j = bid; j < 64; j += nb) {
        const int which = j >> 5, r0 = (j & 31) * 32;
        const float* part = (const float*)(p.ws + OFF_CPART) + (size_t)which * 1024 * 256; const float* bias = (const float*)(p.ws + OFF_BIAS1) + which * 256;
#pragma unroll
        for (int it = 0; it < 4; ++it) { const int id = tid + 512 * it, r = id >> 6, c4 = (id & 63) * 4;
            f32x4 s = *(const f32x4*)(bias + c4);
#pragma unroll
            for (int ks = 0; ks < 8; ++ks) s += *(const f32x4*)(part + (size_t)ks * 2 * 1024 * 256 + (size_t)(r0 + r) * 256 + c4);
            uint2 o; o.x = pack2(silu_f(s[0]), silu_f(s[1])); o.y = pack2(silu_f(s[2]), silu_f(s[3]));
            *(uint2*)(sH + r * HS + c4) = o; }
        __syncthreads();
        if (wv < 4) {
            const bf16_t* w2 = (const bf16_t*)(p.ws + OFF_W2T) + (size_t)which * 128 * 256;
            f32x16 acc;
#pragma unroll
            for (int r = 0; r < 16; ++r) acc[r] = 0.f;
#pragma unroll
            for (int s = 0; s < 16; ++s) { const bf16x8 av = *(const bf16x8*)(sH + (lane & 31) * HS + 16 * s + 8 * (lane >> 5));
                const bf16x8 bv = *(const bf16x8*)(w2 + (size_t)(32 * wv + (lane & 31)) * 256 + 16 * s + 8 * (lane >> 5));
                acc = MFMA32(av, bv, acc); }
            bf16_t* o = (bf16_t*)(p.ws + OFF_KVC) + (size_t)which * 1024 * 128;
#pragma unroll
            for (int r = 0; r < 16; ++r) o[(size_t)(r0 + (r & 3) + 8 * (r >> 2) + 4 * (lane >> 5)) * 128 + 32 * wv + (lane & 31)] = f2bf(acc[r]);
        }
        __syncthreads();
    }
}

constexpr int SHS = 2052;
__device__ __forceinline__ void phase_router(const Params& p, int bid, int nb, unsigned char* smem, int cnt_off = 0) {
    float* sh = (float*)smem;
    const float* x1 = (const float*)(p.ws + OFF_X1); const float* mod = (const float*)(p.ws + OFF_MOD);
    bf16_t* h2 = (bf16_t*)(p.ws + OFF_H);
    int* tkidx = (int*)(p.ws + OFF_TKIDX); float* tkw = (float*)(p.ws + OFF_TKW); int* slot = (int*)(p.ws + OFF_SLOT);
    unsigned* cnt = (unsigned*)(p.ws + OFF_CTRL) + CW_CNT + cnt_off;
    const int tid = opaque((int)threadIdx.x), lane = tid & 63, wv = tid >> 6;
    for (int batch = bid; batch < NTOK / 16; batch += nb) {
        const int r0 = batch * 16;
#pragma unroll 1
        for (int rr = 0; rr < 2; ++rr) {
            const int lr = wv * 2 + rr, row = r0 + lr, b = row / T;
            const float* xr = x1 + (size_t)row * D;
            f32x4 v[8]; float ss = 0.f;
#pragma unroll
            for (int c = 0; c < 8; ++c) { v[c] = *(const f32x4*)(xr + (c * 64 + lane) * 4); ss += v[c][0] * v[c][0] + v[c][1] * v[c][1] + v[c][2] * v[c][2] + v[c][3] * v[c][3]; }
            ss = wave_sum(ss);
            const float rstd = rsqrtf(ss * (1.f / D) + 1e-6f);
            const float* shf = mod + b * 12288 + 3 * 2048; const float* sc = mod + b * 12288 + 4 * 2048;
#pragma unroll
            for (int c = 0; c < 8; ++c) { const int col = (c * 64 + lane) * 4;
                const f32x4 w = *(const f32x4*)(p.norm_ffn_w + col), s1 = *(const f32x4*)(sc + col), s0 = *(const f32x4*)(shf + col);
                f32x4 o;
#pragma unroll
                for (int q = 0; q < 4; ++q) o[q] = v[c][q] * rstd * w[q] * (1.f + s1[q]) + s0[q];
                *(f32x4*)(sh + lr * SHS + col) = o;
                uint2 pk; pk.x = pack2(o[0], o[1]); pk.y = pack2(o[2], o[3]);
                *(uint2*)(h2 + (size_t)row * D + col) = pk; }
        }
        __syncthreads();
        f32x4 acc[4];
#pragma unroll
        for (int nt = 0; nt < 4; ++nt) acc[nt] = (f32x4){0.f, 0.f, 0.f, 0.f};
        {
            const float* ap = sh + (lane & 15) * SHS + 256 * wv + (lane >> 4);
            const float* bp = (const float*)(p.ws + OFF_RWP) + (size_t)(256 * wv + (lane >> 4)) * 64 + 4 * (lane & 15);
#pragma unroll 8
            for (int s = 0; s < 64; ++s) {
                const float av = ap[4 * s];
                const f32x4 bv = *(const f32x4*)(bp + (size_t)s * 256);
#pragma unroll
                for (int nt = 0; nt < 4; ++nt) acc[nt] = __builtin_amdgcn_mfma_f32_16x16x4f32(av, bv[nt], acc[nt], 0, 0, 0);
            }
        }
        __syncthreads();
#pragma unroll
        for (int nt = 0; nt < 4; ++nt)
#pragma unroll
            for (int i = 0; i < 4; ++i) sh[(wv * 16 + 4 * (lane >> 4) + i) * 64 + 16 * nt + (lane & 15)] = acc[nt][i];
        __syncthreads();
        const float bias = p.router_bias[lane];
        unsigned* lcnt = (unsigned*)(sh + 8 * 16 * 64);
        if (tid < 64) lcnt[tid] = 0u;
        __syncthreads();
        int rnk[2]; unsigned loc[2];
#pragma unroll
        for (int rr = 0; rr < 2; ++rr) {
            const int lr = wv * 2 + rr, row = r0 + lr;
            float lg = 0.f;
#pragma unroll
            for (int w = 0; w < 8; ++w) lg += sh[(w * 16 + lr) * 64 + lane];
            const float score = sigmoid_f(lg), key = score + bias;
            int rank = 0;
            for (int j = 0; j < 64; ++j) { const float kj = __shfl(key, j); rank += (kj > key || (kj == key && j < lane)) ? 1 : 0; }
            const bool sel = rank < 8;
            const float ssum = wave_sum(sel ? score : 0.f);
            rnk[rr] = sel ? rank : -1; loc[rr] = 0u;
            if (sel) { tkidx[row * 8 + rank] = lane; tkw[row * 8 + rank] = score / ssum * 2.5f; loc[rr] = atomicAdd(&lcnt[lane], 1u); }
        }
        __syncthreads();
        if (tid < 64) lcnt[64 + tid] = atomicAdd(&cnt[tid], lcnt[tid]);
        __syncthreads();
#pragma unroll
        for (int rr = 0; rr < 2; ++rr) if (rnk[rr] >= 0) slot[(r0 + wv * 2 + rr) * 8 + rnk[rr]] = (int)(lcnt[64 + lane] + loc[rr]);
        __syncthreads();
    }
}

__device__ __forceinline__ void moe_offsets(const Params& p, int* offs) {
    if (opaque((int)threadIdx.x) == 0) { const unsigned* cnt = (const unsigned*)(p.ws + OFF_CTRL) + CW_CNT; int s = 0;
        for (int e = 0; e < 64; ++e) { offs[e] = s; s += (int)cnt[e]; }
        offs[64] = s; offs[65] = s + NTOK; }
    __syncthreads();
}
__device__ __forceinline__ void phase_scatter(const Params& p, int bid, int nb, unsigned char* smem) {
    int* offs = (int*)smem; moe_offsets(p, offs);
    const int* tkidx = (const int*)(p.ws + OFF_TKIDX); const float* tkw = (const float*)(p.ws + OFF_TKW); const int* slot = (const int*)(p.ws + OFF_SLOT);
    int* pos = (int*)(p.ws + OFF_POS); int* stok = (int*)(p.ws + OFF_STOK); float* roww = (float*)(p.ws + OFF_ROWW);
    const int tid = opaque((int)threadIdx.x);
    for (int i = bid * NTHR + tid; i < NTOK * 8; i += nb * NTHR) {
        const int e = tkidx[i], ps = offs[e] + slot[i];
        pos[i] = ps; stok[ps] = i >> 3; roww[ps] = tkw[i];
    }
    for (int t = bid * NTHR + tid; t < NTOK; t += nb * NTHR) { stok[NTOK * 8 + t] = t; roww[NTOK * 8 + t] = 1.f; }
}

__device__ __forceinline__ void phase_moe_gemm(const Params& p, int which, int bid, int nb, unsigned char* smem) {
    int* offs = (int*)(smem + 2 * 128 * GS * 2); int* tst = offs + 72;
    moe_offsets(p, offs);
    const int ntn = which ? 16 : 8;
    if (opaque((int)threadIdx.x) == 0) { int s = 0; for (int e = 0; e < 65; ++e) { tst[e] = s; s += ((offs[e + 1] - offs[e] + 127) >> 7) * ntn; } tst[65] = s; }
    __syncthreads();
    const int total = tst[65];
    const bf16_t* h2 = (const bf16_t*)(p.ws + OFF_H); bf16_t* act = (bf16_t*)(p.ws + OFF_ACT); bf16_t* y = (bf16_t*)(p.ws + OFF_Y);
    const int* stok = (const int*)(p.ws + OFF_STOK); const float* roww = (const float*)(p.ws + OFF_ROWW);
    for (int t = bid; t < total; t += nb) {
        int e = 0; while (t >= tst[e + 1]) ++e;
        const int loc = t - tst[e], mt = (offs[e + 1] - offs[e] + 127) >> 7, m0 = offs[e] + (loc % mt) * 128, n0 = (loc / mt) * 128;
        if (which == 0) {
            ARowGather af{h2, D, stok, offs[e + 1] - 1}; BRowGateUp bf{(const bf16_t*)(p.ws + OFF_GUT) + (size_t)e * 1024 * 2048, 2048}; EpiAct epi{act, offs[e + 1]};
            gemm_tile128(af, bf, 0, 2048, m0, n0, epi, smem);
        } else {
            ARowDirect af{act, EFF}; BRowDirect bf{(const bf16_t*)(p.ws + OFF_DNT) + (size_t)e * 2048 * 512, 512}; EpiY epi{y, roww, offs[e + 1]};
            gemm_tile128(af, bf, 0, 512, m0, n0, epi, smem);
        }
    }
}

__device__ __forceinline__ void phase_final(const Params& p, int bid, int nb, unsigned char* smem) {
    const float* x1 = (const float*)(p.ws + OFF_X1); const float* mod = (const float*)(p.ws + OFF_MOD);
    const bf16_t* y = (const bf16_t*)(p.ws + OFF_Y); const int* pos = (const int*)(p.ws + OFF_POS);
    const int tid_ = opaque((int)threadIdx.x); const int lane = tid_ & 63, wv = tid_ >> 6;
    float* srow = (float*)smem + wv * 2048;
    for (int row = bid * 8 + wv; row < NTOK; row += nb * 8) {
        const int b = row / T;
        const float* gm = mod + b * 12288 + 5 * 2048;
        const int* prow = pos + row * 8; const float* wrow = (const float*)(p.ws + OFF_TKW) + row * 8;
        float ss = 0.f;
#pragma unroll 4
        for (int c = 0; c < 8; ++c) { const int col = (c * 64 + lane) * 4;
            float acc[4] = {0.f, 0.f, 0.f, 0.f};
#pragma unroll
            for (int k = 0; k < 9; ++k) { const int pr = (k < 8) ? prow[k] : (NTOK * 8 + row); const float wk = (k < 8) ? wrow[k] : 1.f; const uint2 u = *(const uint2*)(y + (size_t)pr * D + col);
                acc[0] += wk * bf2f((bf16_t)(u.x & 0xffff)); acc[1] += wk * bf2f((bf16_t)(u.x >> 16)); acc[2] += wk * bf2f((bf16_t)(u.y & 0xffff)); acc[3] += wk * bf2f((bf16_t)(u.y >> 16)); }
            const f32x4 xv = *(const f32x4*)(x1 + (size_t)row * D + col), g = *(const f32x4*)(gm + col);
            f32x4 v;
#pragma unroll
            for (int q = 0; q < 4; ++q) { v[q] = xv[q] + g[q] * acc[q]; ss += v[q] * v[q]; }
            *(f32x4*)(srow + col) = v; }
        ss = wave_sum(ss);
        const float rstd = rsqrtf(ss * (1.f / D) + 1e-6f);
#pragma unroll 1
        for (int c = 0; c < 8; ++c) { const int col = (c * 64 + lane) * 4; const f32x4 w = *(const f32x4*)(p.norm_final_w + col); const f32x4 v = *(const f32x4*)(srow + col);
            f32x4 o;
#pragma unroll
            for (int q = 0; q < 4; ++q) o[q] = v[q] * rstd * w[q];
            *(f32x4*)(p.out + (size_t)row * D + col) = o; }
    }
}

namespace g8 {
#define G8_LAS __attribute__((address_space(3)))
typedef unsigned u32x4 __attribute__((ext_vector_type(4)));
constexpr int BM = 256, BK = 64, HALF = 128, HTB = HALF * BK * 2, STAGE_BYTES = 8 * HTB;
__device__ __forceinline__ int lds_byte(int r, int c) { const int st = (r >> 4) * 2 + (c >> 5), rr = r & 15, cc = c & 31, ob = rr * 64 + cc * 2; return st * 1024 + (ob ^ (((ob >> 9) & 1) << 5)); }
__device__ __forceinline__ void stage_rc(int b, int& R, int& C) { const int st = b / 1024, sb = b % 1024, swz = sb ^ (((sb >> 9) & 1) << 5); R = (st >> 1) * 16 + swz / 64; C = (st & 1) * 32 + (swz % 64) / 2; }
__device__ __forceinline__ int perm32r(int rho) { const int n = rho >> 4, i = rho & 15; return 8 * (i >> 2) + 4 * n + (i & 3); }
__device__ __forceinline__ unsigned cvt_pk_bf16(float lo, float hi) { return pack2(lo, hi); }

struct Unit { int m0, pn, rend, e; };

struct DenseSched { int nM, nN, nwg, G, c;
    __device__ void init(int M, int N, int G_, int c_) { nM = M / BM; nN = N / BM; nwg = nM * nN; G = G_; c = c_; }
    __device__ bool next(int i, Unit& u) const {
        const long L = (long)i * G + c; if (L >= nwg) return false;
        int wgid = (int)L; { const int q = nwg / 8, r = nwg % 8, xcd = wgid % 8, off = wgid / 8; wgid = (xcd < r ? xcd * (q + 1) : r * (q + 1) + (xcd - r) * q) + off; }
        const int nig = 8 * nN, gid = wgid / nig, fm = gid * 8, gsz = (nM - fm) < 8 ? (nM - fm) : 8;
        u.m0 = (fm + ((wgid % nig) % gsz)) * BM; u.pn = (wgid % nig) / gsz; u.rend = 0x7fffffff; u.e = 0; return true; } };
struct MoeSched { const G8_LAS int* tst; const G8_LAS int* offs; int G, c; mutable int ehint; int ntn;
    __device__ bool next(int i, Unit& u) const {
        const int nwg = tst[65]; const int L0 = i * G + c; if (L0 >= nwg) return false;
        int L; { const int q = nwg / 8, r = nwg % 8, xcd = L0 % 8, off = L0 / 8; L = (xcd < r ? xcd * (q + 1) : r * (q + 1) + (xcd - r) * q) + off; }
        int e = (L >= tst[ehint]) ? ehint : 0; while (L >= tst[e + 1]) ++e; ehint = e;
        const int loc = L - tst[e], mt = (offs[e + 1] - offs[e] + 255) >> 8;
        (void)mt; u.m0 = offs[e] + (loc / ntn) * BM; u.pn = loc % ntn; u.rend = offs[e + 1]; u.e = e; return true; } };
struct ADirect { static constexpr bool LOADS = false; unsigned K2; __device__ __forceinline__ unsigned off(const Unit& u, int r) const { return (unsigned)(u.m0 + r) * K2; } };
struct AGather { static constexpr bool LOADS = true; const int* idx; unsigned K2; __device__ __forceinline__ unsigned off(const Unit& u, int r) const { int rr = u.m0 + r; rr = rr < u.rend ? rr : u.rend - 1; return (unsigned)idx[rr] * K2; } };
struct BDense { const char* Bt; size_t tstep; __device__ __forceinline__ const char* base(const Unit& u) const { return Bt + (size_t)u.pn * tstep; } };
struct BGroup { const char* Bt; size_t tstep, estride; __device__ __forceinline__ const char* base(const Unit& u) const { return Bt + (size_t)u.e * estride + (size_t)u.pn * tstep; } };

struct EpiProj8 { static constexpr bool PERM = true; bf16_t* proj; float* small;
    __device__ __forceinline__ void operator()(const f32x4 (&acc)[2][2][4][2], const Unit& u, int wr, int wc, int fr, int fq) const {
#pragma unroll
        for (int ai = 0; ai < 2; ++ai)
#pragma unroll
            for (int m = 0; m < 4; ++m) { const int row = u.m0 + ai * HALF + wr * 64 + m * 16 + fr;
#pragma unroll
                for (int bj = 0; bj < 2; ++bj) { const int col = u.pn * BM + bj * HALF + wc * 32 + 8 * fq; const f32x4 v0 = acc[ai][bj][m][0], v1 = acc[ai][bj][m][1];
                    if (col < C_SMALL) { u32x4 w; w.x = cvt_pk_bf16(v0[0], v0[1]); w.y = cvt_pk_bf16(v0[2], v0[3]); w.z = cvt_pk_bf16(v1[0], v1[1]); w.w = cvt_pk_bf16(v1[2], v1[3]);
                        *(u32x4*)(proj + (size_t)row * PROJ_LD + col) = w; }
                    else if (col < C_SMALL + 40) { float* sp = small + (size_t)row * 64 + (col - C_SMALL); *(f32x4*)sp = v0; *(f32x4*)(sp + 4) = v1; } } }
    } };
struct EpiOut8 { static constexpr bool PERM = false; const float* x; const float* mod; float* x1;
    __device__ __forceinline__ void operator()(const f32x4 (&acc)[2][2][4][2], const Unit& u, int wr, int wc, int fr, int fq) const {
        const float* g = mod + (u.m0 / T) * 12288 + 2 * 2048;
#pragma unroll
        for (int ai = 0; ai < 2; ++ai)
#pragma unroll
            for (int m = 0; m < 4; ++m) { const int row = u.m0 + ai * HALF + wr * 64 + m * 16 + fr;
#pragma unroll
                for (int bj = 0; bj < 2; ++bj)
#pragma unroll
                    for (int n = 0; n < 2; ++n) { const int col = u.pn * BM + bj * HALF + wc * 32 + 16 * n + 4 * fq; const size_t o = (size_t)row * D + col;
                        const f32x4 xv = *(const f32x4*)(x + o), gv = *(const f32x4*)(g + col); *(f32x4*)(x1 + o) = xv + gv * acc[ai][bj][m][n]; } }
    } };
struct EpiAct8 { static constexpr bool PERM = true; bf16_t* act;
    __device__ __forceinline__ void operator()(const f32x4 (&acc)[2][2][4][2], const Unit& u, int wr, int wc, int fr, int fq) const {
#pragma unroll
        for (int ai = 0; ai < 2; ++ai)
#pragma unroll
            for (int m = 0; m < 4; ++m) { const int row = u.m0 + ai * HALF + wr * 64 + m * 16 + fr;
                if (row < u.rend) { float r[8];
#pragma unroll
                    for (int n = 0; n < 2; ++n)
#pragma unroll
                        for (int j = 0; j < 4; ++j) r[4 * n + j] = silu_f(acc[ai][0][m][n][j]) * acc[ai][1][m][n][j];
                    u32x4 w; w.x = cvt_pk_bf16(r[0], r[1]); w.y = cvt_pk_bf16(r[2], r[3]); w.z = cvt_pk_bf16(r[4], r[5]); w.w = cvt_pk_bf16(r[6], r[7]);
                    *(u32x4*)(act + (size_t)row * EFF + u.pn * HALF + wc * 32 + 8 * fq) = w; } }
    } };
struct EpiY8 { static constexpr bool PERM = true; bf16_t* y; const float* roww;
    __device__ __forceinline__ void operator()(const f32x4 (&acc)[2][2][4][2], const Unit& u, int wr, int wc, int fr, int fq) const {
#pragma unroll
        for (int ai = 0; ai < 2; ++ai)
#pragma unroll
            for (int m = 0; m < 4; ++m) { const int row = u.m0 + ai * HALF + wr * 64 + m * 16 + fr;
                if (row < u.rend) {
#pragma unroll
                    for (int bj = 0; bj < 2; ++bj) { const f32x4 v0 = acc[ai][bj][m][0], v1 = acc[ai][bj][m][1];
                        u32x4 w; w.x = cvt_pk_bf16(v0[0], v0[1]); w.y = cvt_pk_bf16(v0[2], v0[3]); w.z = cvt_pk_bf16(v1[0], v1[1]); w.w = cvt_pk_bf16(v1[2], v1[3]);
                        *(u32x4*)(y + (size_t)row * D + u.pn * BM + bj * HALF + wc * 32 + 8 * fq) = w; } } }
    } };

template <class Epi, class Sched, class AOff, class BBase>
__device__ __forceinline__ void gemm_phase(G8_LAS unsigned char* lds, const int K, const Sched& S, const Epi& E, const AOff& AO, const char* Abase, const BBase& BB) {
    const int tid = opaque((int)threadIdx.x), wid = __builtin_amdgcn_readfirstlane(tid >> 6), lane = tid & 63, wr = wid >> 2, wc = wid & 3, fr = lane & 15, fq = lane >> 4;
    const int nt = K / BK;
    int RA[2], CA2[2]; unsigned voffB[2];
#pragma unroll
    for (int i = 0; i < 2; ++i) { int R, C; stage_rc(tid * 16 + i * 8192, R, C); const int Rb = Epi::PERM ? ((R & ~31) + perm32r(R & 31)) : R;
        RA[i] = R; CA2[i] = C * 2; voffB[i] = (unsigned)(Rb * K + C) * 2u; }
    const size_t kstep = (size_t)(BK * 2);
    const size_t hstep = (size_t)HALF * K * 2;
    const unsigned ldsw = (unsigned)wid * 1024u;
    const int aoff = lds_byte(wr * 64 + fr, fq * 8), boff = lds_byte(wc * 32 + fr, fq * 8);
#define G8_SA(b, h) (((b) * 2 + (h)) * HTB)
#define G8_SB(b, h) ((4 + (b) * 2 + (h)) * HTB)
#define G8_STAGE(bufoff, gbase, voff) do { _Pragma("unroll") for (int _i = 0; _i < 2; ++_i) \
        __builtin_amdgcn_global_load_lds((const unsigned*)((const char*)(gbase) + (voff)[_i]), (G8_LAS unsigned*)(lds + (bufoff) + ldsw + _i * 8192), 16, 0, 0); } while (0)
#define G8_LDA(dst, b, h) do { _Pragma("unroll") for (int m = 0; m < 4; ++m) _Pragma("unroll") for (int k = 0; k < 2; ++k) dst[m][k] = *(const G8_LAS bf16x8*)(lds + G8_SA(b, h) + aoff + m * 2048 + k * 1024); } while (0)
#define G8_LDB(dst, b, h) do { _Pragma("unroll") for (int n = 0; n < 2; ++n) _Pragma("unroll") for (int k = 0; k < 2; ++k) dst[n][k] = *(const G8_LAS bf16x8*)(lds + G8_SB(b, h) + boff + n * 2048 + k * 1024); } while (0)
#define G8_MMA(ai, bj, At, Bt) do { __builtin_amdgcn_s_setprio(1); _Pragma("unroll") for (int m = 0; m < 4; ++m) _Pragma("unroll") for (int n = 0; n < 2; ++n) _Pragma("unroll") for (int k = 0; k < 2; ++k) \
        acc[ai][bj][m][n] = __builtin_amdgcn_mfma_f32_16x16x32_bf16(Bt[n][k], At[m][k], acc[ai][bj][m][n], 0, 0, 0); __builtin_amdgcn_s_setprio(0); } while (0)
#define G8_WAIT_V(n) asm volatile("s_waitcnt vmcnt(" #n ")" ::: "memory")
#define G8_WAIT_L(n) asm volatile("s_waitcnt lgkmcnt(" #n ")" ::: "memory")
#define G8_BAR __builtin_amdgcn_s_barrier()
#define G8_SCHED __builtin_amdgcn_sched_barrier(0)
#define G8_AOFF(dst, un) do { _Pragma("unroll") for (int _h = 0; _h < 2; ++_h) _Pragma("unroll") for (int _i = 0; _i < 2; ++_i) dst[_h][_i] = AO.off(un, _h * HALF + RA[_i]) + (unsigned)CA2[_i]; } while (0)
    Unit cur, nxt; int ui = 0;
    if (!S.next(0, cur)) return;
    f32x4 acc[2][2][4][2];
#pragma unroll
    for (int a = 0; a < 2; ++a)
#pragma unroll
        for (int b = 0; b < 2; ++b)
#pragma unroll
            for (int m = 0; m < 4; ++m)
#pragma unroll
                for (int n = 0; n < 2; ++n) acc[a][b][m][n] = (f32x4){0.f, 0.f, 0.f, 0.f};
    bf16x8 At[4][2], B0[2][2], B1[2][2];
    unsigned vA[2][2];
    G8_AOFF(vA, cur);
    asm volatile("s_waitcnt vmcnt(0)" ::: "memory");
    const char* cB = BB.base(cur);
    G8_STAGE(G8_SB(0, 0), cB, voffB); G8_STAGE(G8_SA(0, 0), Abase, vA[0]); G8_STAGE(G8_SB(0, 1), cB + hstep, voffB); G8_STAGE(G8_SA(0, 1), Abase, vA[1]);
    if (wr == 1) G8_BAR;
    G8_WAIT_V(4); G8_BAR;
    G8_STAGE(G8_SB(1, 0), cB + kstep, voffB); G8_STAGE(G8_SA(1, 0), Abase + kstep, vA[0]); G8_STAGE(G8_SB(1, 1), cB + hstep + kstep, voffB);
    G8_WAIT_V(6); G8_BAR;
    for (;;) {
        const bool has_next = S.next(ui + 1, nxt);
        const char* nB = has_next ? BB.base(nxt) : cB;
        for (int t = 0; t < nt; t += 2) {
            const bool last = (t == nt - 2);
            const char* a1 = Abase + (size_t)(t + 1) * kstep;
            const char* a2 = last ? Abase : Abase + (size_t)(t + 2) * kstep; const char* b2 = last ? nB : cB + (size_t)(t + 2) * kstep;
            const char* a3 = a2 + kstep; const char* b3 = b2 + kstep;
            G8_LDB(B0, 0, 0); G8_SCHED; G8_LDA(At, 0, 0); G8_STAGE(G8_SA(1, 1), a1, vA[1]);
            if (last && has_next) { G8_AOFF(vA, nxt); if (AOff::LOADS) asm volatile("s_waitcnt vmcnt(0)" ::: "memory"); }
            G8_WAIT_L(8); G8_BAR; G8_WAIT_L(0); G8_MMA(0, 0, At, B0); G8_BAR; G8_SCHED;
            G8_LDB(B1, 0, 1); G8_STAGE(G8_SB(0, 0), b2, voffB);
            G8_BAR; G8_WAIT_L(0); G8_MMA(0, 1, At, B1); G8_BAR;
            G8_LDA(At, 0, 1); G8_STAGE(G8_SA(0, 0), a2, vA[0]);
            G8_BAR; G8_WAIT_L(0); G8_MMA(1, 0, At, B0); G8_BAR; G8_SCHED;
            G8_STAGE(G8_SB(0, 1), b2 + hstep, voffB);
            G8_WAIT_V(6); G8_BAR; G8_MMA(1, 1, At, B1); G8_BAR;
            G8_LDB(B0, 1, 0); G8_SCHED; G8_LDA(At, 1, 0); G8_STAGE(G8_SA(0, 1), a2, vA[1]);
            G8_WAIT_L(8); G8_BAR; G8_WAIT_L(0); G8_MMA(0, 0, At, B0); G8_BAR; G8_SCHED;
            G8_LDB(B1, 1, 1); G8_STAGE(G8_SB(1, 0), b3, voffB);
            G8_BAR; G8_WAIT_L(0); G8_MMA(0, 1, At, B1); G8_BAR;
            G8_LDA(At, 1, 1); G8_STAGE(G8_SA(1, 0), a3, vA[0]);
            G8_BAR; G8_WAIT_L(0); G8_MMA(1, 0, At, B0); G8_BAR; G8_SCHED;
            G8_STAGE(G8_SB(1, 1), b3 + hstep, voffB);
            G8_WAIT_V(6); G8_BAR; G8_MMA(1, 1, At, B1); G8_BAR;
        }
        E(acc, cur, wr, wc, fr, fq);
        if (!has_next) break;
#pragma unroll
        for (int a = 0; a < 2; ++a)
#pragma unroll
            for (int b = 0; b < 2; ++b)
#pragma unroll
                for (int m = 0; m < 4; ++m)
#pragma unroll
                    for (int n = 0; n < 2; ++n) acc[a][b][m][n] = (f32x4){0.f, 0.f, 0.f, 0.f};
        cur = nxt; cB = nB; ++ui;
    }
    G8_WAIT_V(0);
    if (wr == 0) G8_BAR;
    G8_BAR;
#undef G8_SA
#undef G8_SB
#undef G8_STAGE
#undef G8_LDA
#undef G8_LDB
#undef G8_MMA
#undef G8_WAIT_V
#undef G8_WAIT_L
#undef G8_BAR
#undef G8_SCHED
#undef G8_AOFF
}
}

__device__ __forceinline__ void phase_moe_gemm8(const Params& p, int which, int bid, int nb, unsigned char* smem) {
    int* offs = (int*)(smem + g8::STAGE_BYTES); int* tst = offs + 72;
    moe_offsets(p, offs);
    const int ntn = which ? 8 : 4;
    if (opaque((int)threadIdx.x) == 0) { int s = 0; for (int e = 0; e < 65; ++e) { tst[e] = s; s += ((offs[e + 1] - offs[e] + 255) >> 8) * ntn; } tst[65] = s; }
    __syncthreads();
    g8::MoeSched S{(const G8_LAS int*)tst, (const G8_LAS int*)offs, nb, bid, 0, ntn};
    if (which == 0) {
        g8::EpiAct8 E{(bf16_t*)(p.ws + OFF_ACT)}; g8::AGather AO{(const int*)(p.ws + OFF_STOK), (unsigned)(D * 2)};
        g8::BGroup BB{(const char*)(p.ws + OFF_GUT), (size_t)256 * 2048 * 2, (size_t)1024 * 2048 * 2};
        g8::gemm_phase((G8_LAS unsigned char*)smem, 2048, S, E, AO, (const char*)(p.ws + OFF_H), BB);
    } else {
        g8::EpiY8 E{(bf16_t*)(p.ws + OFF_Y), (const float*)(p.ws + OFF_ROWW)}; g8::ADirect AO{(unsigned)(EFF * 2)};
        g8::BGroup BB{(const char*)(p.ws + OFF_DNT), (size_t)256 * 512 * 2, (size_t)2048 * 512 * 2};
        g8::gemm_phase((G8_LAS unsigned char*)smem, 512, S, E, AO, (const char*)(p.ws + OFF_ACT), BB);
    }
    __syncthreads();
}

constexpr int LDS_BYTES = LDS_BYTES_C;

__global__ void __launch_bounds__(512, 2) k_mega(Params p) {
    const int bid = blockIdx.x, nb = gridDim.x;
    unsigned char* smem = dyn_smem;
    unsigned* ctrl = (unsigned*)(p.ws + OFF_CTRL);
    volatile LAS unsigned* xbw = (volatile LAS unsigned*)(dyn_smem + LDS_BYTES - 16);
    if (threadIdx.x == 0) { xbw[0] = 0u; xbw[1] = 0u; xbw[2] = 0u; xbw[3] = 0u; LAS int* qs = (LAS int*)(dyn_smem + LDS_BYTES - 128); qs[3] = 0; qs[4] = 0; }
    __syncthreads();
    XcdBarrier bar = xcd_barrier_post(ctrl, xbw);
    const float* mod = (const float*)(p.ws + OFF_MOD);
#ifndef REPEAT_PHASE
#define REPEAT_PHASE -1
#endif
#define REP(k) for (int rep_ = 0; rep_ < ((REPEAT_PHASE == (k)) ? 2 : 1); ++rep_, ((REPEAT_PHASE == (k)) && rep_ == 1) ? xcd_barrier(bar) : (void)0)
    REP(0) phase_prologue(p, bid, nb, smem);
    xcd_barrier(bar);
    REP(1) phase_modulate(p.x, p.norm_attn_w, mod, 0, 1, (bf16_t*)(p.ws + OFF_H), bid, nb);
    xcd_barrier(bar);
    if (nb == 256 && bid >= 216) phase_expert_convert(p, &ctrl[CW_Q0 + 128], smem, 48);
    else REP(2) { g8::DenseSched S; S.init(NTOK, PROJ_LD, nb == 256 ? 216 : nb, bid); g8::EpiProj8 E{(bf16_t*)(p.ws + OFF_PROJ), (float*)(p.ws + OFF_SMALL)}; g8::ADirect AO{(unsigned)(D * 2)};
      g8::BDense BB{(const char*)(p.ws + OFF_WINT), (size_t)256 * D * 2};
      g8::gemm_phase((G8_LAS unsigned char*)smem, D, S, E, AO, (const char*)(p.ws + OFF_H), BB); }
    xcd_barrier_work(bar, p, &ctrl[CW_Q0 + 128], smem);
    REP(3) { phase_cmp1(p, bid, nb, smem); phase_gdn_prep(p, bid, nb, smem); }
    xcd_barrier_work(bar, p, &ctrl[CW_Q0 + 128], smem);
    REP(5) phase_cmp2(p, bid, nb, smem);
    xcd_barrier_work(bar, p, &ctrl[CW_Q0 + 128], smem);
    REP(6) {
    for (int j = bid; j < 16; j += nb) phase_gdn_scan(p, j, smem);
    constexpr int CONV_FIRST = 80;
    const bool conv_first = (nb >= 192) && (bid >= nb - CONV_FIRST);
    for (int stg = 0; stg < 2; ++stg) {
        if ((stg == 0) == conv_first) phase_expert_convert(p, &ctrl[CW_Q0 + 128], smem);
        else {
            LAS int* qslot = (LAS int*)(dyn_smem + LDS_BYTES - 32);
            for (;;) {
                __syncthreads();
                if (threadIdx.x == 0) *qslot = (int)__hip_atomic_fetch_add(&ctrl[CW_Q0 + 64 * rep_], 1u, __ATOMIC_RELAXED, __HIP_MEMORY_SCOPE_AGENT);
                __syncthreads();
                const int i = *qslot;
                if (i >= 256) break;
                nsa_job(p, ((i & 3) << 6) | (63 - (i >> 2)), smem);
            }
        }
    }
    }
    xcd_barrier_work(bar, p, &ctrl[CW_Q0 + 128], smem);
    REP(13) phase_gdn_out(p, bid, nb, smem);
    xcd_barrier(bar);
    REP(7) { g8::DenseSched S; S.init(NTOK, D, nb, bid); g8::EpiOut8 E{p.x, mod, (float*)(p.ws + OFF_X1)}; g8::ADirect AO{(unsigned)(D * 2)};
      g8::BDense BB{(const char*)(p.ws + OFF_WOUTT), (size_t)256 * D * 2};
      g8::gemm_phase((G8_LAS unsigned char*)smem, D, S, E, AO, (const char*)(p.ws + OFF_YCAT), BB); }
    xcd_barrier(bar);
    REP(8) phase_router(p, bid, nb, smem, (REPEAT_PHASE == 8 && rep_ == 0) ? 128 : 0);
    xcd_barrier(bar);
    REP(9) phase_scatter(p, bid, nb, smem);
    xcd_barrier(bar);
    REP(10) phase_moe_gemm8(p, 0, bid, nb, smem);
    xcd_barrier(bar);
    REP(11) phase_moe_gemm8(p, 1, bid, nb, smem);
    xcd_barrier(bar);
    REP(12) phase_final(p, bid, nb, smem);
}

extern "C" void kernel_launch(void* const* d_in, const int* in_sizes, int n_in, void* d_out, int out_size, void* d_ws, size_t ws_size, hipStream_t stream) {
    (void)in_sizes; (void)n_in; (void)out_size; (void)ws_size;
    Params p{};
    const float** f = (const float**)&p;
    for (int i = 0; i < 27; ++i) f[i] = (const float*)d_in[i];
    p.out = (float*)d_out; p.ws = (unsigned char*)d_ws;
    static int grid = 0;
    if (!grid) {
        int dev = 0, cus = 0, per_cu = 0;
        (void)hipGetDevice(&dev);
        (void)hipDeviceGetAttribute(&cus, hipDeviceAttributeMultiprocessorCount, dev);
        (void)hipFuncSetAttribute((const void*)k_mega, hipFuncAttributeMaxDynamicSharedMemorySize, LDS_BYTES);
        (void)hipOccupancyMaxActiveBlocksPerMultiprocessor(&per_cu, (const void*)k_mega, NTHR, LDS_BYTES);
        if (cus <= 0) cus = 256;
        grid = cus;
        (void)per_cu;
    }
    (void)hipMemsetAsync((char*)d_ws + OFF_CTRL, 0, CTRL_BYTES, stream);
    hipLaunchKernelGGL(k_mega, dim3(grid), dim3(NTHR), LDS_BYTES, stream, p);
}
```

```cpp
#include <hip/hip_runtime.h>
#include <stdint.h>

typedef unsigned short bf16_t;
typedef short bf16x8 __attribute__((ext_vector_type(8)));
typedef float f32x4 __attribute__((ext_vector_type(4)));
typedef float f32x16 __attribute__((ext_vector_type(16)));

extern __shared__ __attribute__((aligned(16))) unsigned char dyn_smem[];
constexpr int LDS_BYTES_C = 152 * 1024;
__device__ __forceinline__ unsigned char* dyn_smem_base() { return dyn_smem; }
constexpr int NB = 2, T = 4096, NTOK = NB * T, D = 2048;
constexpr int PROJ_LD = 6912;
constexpr int C_QKV = 0, C_GATEG = 3072, C_QN = 4096, C_KCMP = 5120, C_VCMP = 5376, C_KSLC = 5632, C_VSLC = 5888, C_KWIN = 6144, C_VWIN = 6400, C_SMALL = 6656;
constexpr int NEXP = 64, EFF = 512, TOPK = 8;
constexpr int NROWS_MOE = NTOK * TOPK + NTOK;
constexpr int NTHR = 512;

constexpr size_t al256(size_t x) { return (x + 255) & ~(size_t)255; }
constexpr size_t OFF_CTRL = 0;
constexpr size_t CTRL_BYTES = 65536;
constexpr size_t OFF_MOD = OFF_CTRL + CTRL_BYTES;
constexpr size_t OFF_BIAS1 = al256(OFF_MOD + 2 * 12288 * 4);
constexpr size_t OFF_EGL = al256(OFF_BIAS1 + 2 * 256 * 4);
constexpr size_t OFF_X1 = al256(OFF_EGL + 1024 * 4);
constexpr size_t OFF_TKIDX = al256(OFF_X1 + (size_t)NTOK * D * 4);
constexpr size_t OFF_TKW = al256(OFF_TKIDX + (size_t)NTOK * 8 * 4);
constexpr size_t OFF_SLOT = al256(OFF_TKW + (size_t)NTOK * 8 * 4);
constexpr size_t OFF_POS = al256(OFF_SLOT + (size_t)NTOK * 8 * 4);
constexpr size_t OFF_STOK = al256(OFF_POS + (size_t)NTOK * 8 * 4);
constexpr size_t OFF_ROWW = al256(OFF_STOK + (size_t)(NROWS_MOE + 256) * 4);
constexpr size_t OFF_ACT = al256(OFF_ROWW + (size_t)(NROWS_MOE + 256) * 4);
constexpr size_t OFF_DNT = al256(OFF_ACT + (size_t)(NROWS_MOE + 256) * EFF * 2);
constexpr size_t OFF_REGB = al256(OFF_DNT + (size_t)65 * 2048 * 512 * 2);
constexpr size_t OFF_Y = OFF_REGB;
constexpr size_t OFF_WINT = OFF_REGB;
constexpr size_t OFF_WOUTT = al256(OFF_WINT + (size_t)PROJ_LD * D * 2);
constexpr size_t OFF_W1T = al256(OFF_WOUTT + (size_t)D * D * 2);
constexpr size_t OFF_W2T = al256(OFF_W1T + (size_t)2 * 256 * 4096 * 2);
constexpr size_t OFF_GUT = al256(OFF_W2T + (size_t)2 * 128 * 256 * 2);
constexpr size_t OFF_H = al256(OFF_GUT + (size_t)65 * 1024 * 2048 * 2);
constexpr size_t OFF_PROJ = al256(OFF_H + (size_t)NTOK * D * 2);
constexpr size_t OFF_SMALL = al256(OFF_PROJ + (size_t)NTOK * PROJ_LD * 2);
constexpr size_t OFF_GNEGW = al256(OFF_SMALL + (size_t)NTOK * 64 * 4);
constexpr size_t OFF_GQD = al256(OFF_GNEGW + (size_t)1024 * 64 * 128 * 2);
constexpr size_t OFF_GKDT = al256(OFF_GQD + (size_t)1024 * 64 * 128 * 2);
constexpr size_t OFF_GQK = al256(OFF_GKDT + (size_t)1024 * 128 * 64 * 2);
constexpr size_t OFF_GUT2 = al256(OFF_GQK + (size_t)1024 * 64 * 64 * 2);
constexpr size_t OFF_FLAT = al256(OFF_GUT2 + (size_t)1024 * 128 * 64 * 4);
constexpr size_t OFF_HID = al256(OFF_FLAT + (size_t)2 * 1024 * 4096 * 2);
constexpr size_t OFF_KVC = al256(OFF_HID + (size_t)2 * 1024 * 256 * 2);
constexpr size_t OFF_YCAT = al256(OFF_KVC + (size_t)2 * 1024 * 128 * 2);
constexpr size_t OFF_GSB = al256(OFF_YCAT + (size_t)NTOK * D * 2);
constexpr size_t OFF_GVB = al256(OFF_GSB + (size_t)1024 * 8 * 4 * 64 * 16);
constexpr size_t OFF_RWP = al256(OFF_GVB + (size_t)1024 * 8 * 2 * 64 * 16);
constexpr size_t WS_END = al256(OFF_RWP + (size_t)2048 * 64 * 4);
static_assert(OFF_Y + (size_t)NROWS_MOE * 2048 * 2 <= WS_END, "y must fit region B");
static_assert(WS_END <= (size_t)1073741824, "workspace over 1 GiB");

constexpr int CW_CNT = 4096;
constexpr int CW_Q0 = 4352;

struct Params {
    const float *x, *c, *w_ada, *b_ada, *norm_attn_w, *norm_ffn_w, *norm_final_w, *w_in, *conv_w, *a_log, *dt_bias, *gdn_norm_w;
    const float *pe_k, *w1_k, *w2_k, *pe_v, *w1_v, *w2_v, *w_out, *router_w, *router_bias, *e_gate, *e_up, *e_down, *s_gate, *s_up, *s_down;
    float* out;
    unsigned char* ws;
};

typedef __bf16 bf16x2_t __attribute__((ext_vector_type(2)));
typedef float f32x2_t __attribute__((ext_vector_type(2)));
__device__ __forceinline__ unsigned pack2(float lo, float hi) { const f32x2_t v = {lo, hi}; return __builtin_bit_cast(unsigned, __builtin_convertvector(v, bf16x2_t)); }
__device__ __forceinline__ bf16_t f2bf(float f) { return __builtin_bit_cast(unsigned short, (__bf16)f); }
__device__ __forceinline__ float bf2f(bf16_t b) { return __uint_as_float(((unsigned)b) << 16); }
__device__ __forceinline__ float silu_f(float x) { return x / (1.f + __expf(-x)); }
__device__ __forceinline__ float sigmoid_f(float x) { return 1.f / (1.f + __expf(-x)); }
__device__ __forceinline__ float softplus_f(float x) { return fmaxf(x, 0.f) + log1pf(__expf(-fabsf(x))); }
__device__ __forceinline__ int perm32(int dl) { return 8 * ((dl >> 2) & 3) + 4 * (dl >> 4) + (dl & 3); }
__device__ __forceinline__ int perm16(int kl) { return 8 * ((kl >> 2) & 1) + 4 * (kl >> 3) + (kl & 3); }
__device__ __forceinline__ int opaque(int x) { asm volatile("" : "+v"(x)); return x; }
#define LDS_BARRIER() do { __builtin_amdgcn_fence(__ATOMIC_RELEASE, "wavefront"); __builtin_amdgcn_s_waitcnt(0xc07f)  ; __builtin_amdgcn_s_barrier(); __builtin_amdgcn_fence(__ATOMIC_ACQUIRE, "wavefront"); } while (0)
#define MFMA32(a, b, c) __builtin_amdgcn_mfma_f32_32x32x16_bf16((a), (b), (c), 0, 0, 0)
__device__ __forceinline__ float wave_sum(float v) {
#pragma unroll
    for (int o = 32; o > 0; o >>= 1) v += __shfl_xor(v, o);
    return v;
}


#define XB_TMO      128
#define XB_XCNT(j)  (256  + 64 * (j))
#define XB_XSUB(j)  (1280 + 64 * (j))
#define XB_XGEN(j)  (2304 + 64 * (j))
#define XB_TOP      3328
#define XB_TOPGEN   3392
#define XCD_BAR_WORDS 3456
#define XB_SPIN_CAP (1u << 18)
#define LAS __attribute__((address_space(3)))

__device__ __forceinline__ unsigned xb_ld(unsigned* p)              { return __hip_atomic_load(p, __ATOMIC_RELAXED, __HIP_MEMORY_SCOPE_AGENT); }
__device__ __forceinline__ unsigned xb_add(unsigned* p, unsigned v) { return __hip_atomic_fetch_add(p, v, __ATOMIC_RELAXED, __HIP_MEMORY_SCOPE_AGENT); }
__device__ __forceinline__ unsigned xb_xcc_id() { return (unsigned)__builtin_amdgcn_s_getreg((3 << 11) | 20) & 0xFu; }
#define XB_SPIN(cond, bar) do { unsigned _sp = 0; while (cond) { __builtin_amdgcn_s_sleep(1); \
    if ((++_sp & 255u) == 0u) { if (xb_ld(&(bar)[XB_TMO])) break; if (_sp > XB_SPIN_CAP) { atomicAdd(&(bar)[XB_TMO], 1u); break; } } } } while (0)

struct XcdBarrier {
    unsigned* bar; unsigned x;
    volatile LAS unsigned* st;
};

__device__ __forceinline__ XcdBarrier xcd_barrier_post(unsigned* bar, volatile LAS unsigned* st) {
    XcdBarrier b; b.bar = bar; b.x = xb_xcc_id(); b.st = st;
    if (threadIdx.x == 0) (void)xb_add(&bar[XB_XCNT(b.x)], 1u);
    return b;
}
__device__ __forceinline__ void xcd_barrier_complete(unsigned* bar, unsigned x, unsigned& nloc, unsigned& nx) {
    const unsigned G = gridDim.x * gridDim.y * gridDim.z;
    unsigned sum, cnt, mine, sp = 0u;
    for (;;) {
        sum = 0u; cnt = 0u; mine = 0u;
#pragma unroll
        for (unsigned j = 0; j < 16; ++j) { const unsigned c = xb_ld(&bar[XB_XCNT(j)]); sum += c; cnt += (c > 0u) ? 1u : 0u; mine = (j == x) ? c : mine; }
        if (sum == G) break;
        __builtin_amdgcn_s_sleep(1);
        if ((++sp & 255u) == 0u) { if (xb_ld(&bar[XB_TMO])) break; if (sp > XB_SPIN_CAP) { atomicAdd(&bar[XB_TMO], 1u); break; } }
    }
    nloc = mine > 0u ? mine : 1u; nx = cnt > 0u ? cnt : 1u;
}

__device__ __forceinline__ void xcd_barrier(const XcdBarrier& b) {
    asm volatile("s_waitcnt vmcnt(0)" ::: "memory");
    __syncthreads();
    if (threadIdx.x == 0) {
        unsigned* bar = b.bar;
        __builtin_amdgcn_s_waitcnt(0);
        unsigned nloc = b.st[0], nx = b.st[1];
        if (nloc == 0u) { xcd_barrier_complete(bar, b.x, nloc, nx); b.st[0] = nloc; b.st[1] = nx; }
        const unsigned old = xb_add(&bar[XB_XSUB(b.x)], 1u);
        const unsigned gen = old / nloc;
        if (old + 1u == (gen + 1u) * nloc) {
            __builtin_amdgcn_fence(__ATOMIC_RELEASE, "agent");
            asm volatile("s_waitcnt vmcnt(0)" ::: "memory");
            const unsigned og = xb_add(&bar[XB_TOP], 1u);
            const unsigned tg = og / nx;
            if (og + 1u == (tg + 1u) * nx) xb_add(&bar[XB_TOPGEN], 1u);
            else XB_SPIN(xb_ld(&bar[XB_TOPGEN]) == tg, bar);
            __builtin_amdgcn_fence(__ATOMIC_ACQUIRE, "agent");
            xb_add(&bar[XB_XGEN(b.x)], 1u);
            asm volatile("s_waitcnt vmcnt(0)" ::: "memory");
        } else {
            XB_SPIN(xb_ld(&bar[XB_XGEN(b.x)]) == gen, bar);
            __builtin_amdgcn_fence(__ATOMIC_ACQUIRE, "agent");
            asm volatile("s_waitcnt vmcnt(0)" ::: "memory");
        }
    }
    __syncthreads();
}

struct ColFn { const float* p0; const float* p1; int mode; };
__device__ __forceinline__ const float* colptr(const ColFn& f, int n) {
    if (f.mode == 0) return f.p0 + n;
    if (f.mode == 1) {
        int src;
        if (n < 3072) src = n; else if (n < 6656) src = n + 16; else if (n < 6672) src = 3072 + (n - 6656); else if (n < 6696) src = n; else return nullptr;
        return f.p0 + src;
    }
    const int jb = n >> 8, wi = n & 255;
    const long long dlt = (wi < 128) ? 0ll : (long long)(f.p1 - f.p0);
    return f.p0 + dlt + jb * 128 + (wi & 127);
}
struct TileRegs { f32x4 v[8]; };
__device__ __forceinline__ void tp_load(const ColFn& f, int ld_src, int n0, int k0, int tid, TileRegs& r) {
    const int c4 = tid & 31, rp = tid >> 5;
    const float* cp = colptr(f, n0 + 4 * c4);
#pragma unroll
    for (int p = 0; p < 4; ++p)
#pragma unroll
        for (int q = 0; q < 2; ++q) { const int k = k0 + 32 * p + 2 * rp + q; r.v[2 * p + q] = cp ? *(const f32x4*)(cp + (size_t)k * ld_src) : (f32x4){0.f, 0.f, 0.f, 0.f}; }
}
__device__ __forceinline__ void tp_store(const TileRegs& r, bf16_t* dst, int ld_dst, int n0, int k0, int tid, unsigned* tile) {
    const int c4 = tid & 31, rp = tid >> 5;
#pragma unroll
    for (int p = 0; p < 4; ++p)
#pragma unroll
        for (int i = 0; i < 4; ++i) tile[(4 * c4 + i) * 65 + 16 * p + rp] = pack2(r.v[2 * p][i], r.v[2 * p + 1][i]);
    LDS_BARRIER();
    { const int n = tid >> 2, q = tid & 3; const unsigned* tp = tile + n * 65 + q * 16;
      unsigned* dp = (unsigned*)(dst + (size_t)(n0 + n) * ld_dst + k0 + q * 32);
#pragma unroll
      for (int j = 0; j < 4; ++j) { uint4 o; o.x = tp[4 * j]; o.y = tp[4 * j + 1]; o.z = tp[4 * j + 2]; o.w = tp[4 * j + 3]; *(uint4*)(dp + 4 * j) = o; } }
    LDS_BARRIER();
}

constexpr int J_WIN = 54 * 16, J_WOUT = 16 * 16, J_W1 = 2 * 2 * 32, J_W2 = 2 * 2, J_GU = 65 * 8 * 16, J_DN = 65 * 16 * 4;
constexpr int J_TP = J_WIN + J_WOUT + J_W1 + J_W2 + J_GU + J_DN;
constexpr int J_EARLY = J_WIN + J_WOUT + J_W1 + J_W2;
struct TpJob { ColFn f; int ld_src; bf16_t* dst; int ld_dst, n0, k0; };
__device__ __forceinline__ void tp_decode(const Params& p, int j, TpJob& t) {
    if (j < J_WIN) { t.f = ColFn{p.w_in, nullptr, 1}; t.ld_src = 6696; t.dst = (bf16_t*)(p.ws + OFF_WINT); t.ld_dst = 2048; t.n0 = (j >> 4) * 128; t.k0 = (j & 15) * 128; return; }
    j -= J_WIN;
    if (j < J_WOUT) { t.f = ColFn{p.w_out, nullptr, 0}; t.ld_src = 2048; t.dst = (bf16_t*)(p.ws + OFF_WOUTT); t.ld_dst = 2048; t.n0 = (j >> 4) * 128; t.k0 = (j & 15) * 128; return; }
    j -= J_WOUT;
    if (j < J_W1) { const int which = j >> 6, r = j & 63; const float* w = p.w1_k + (which ? (long long)(p.w1_v - p.w1_k) : 0ll);
        t.f = ColFn{w, nullptr, 0}; t.ld_src = 256; t.dst = (bf16_t*)(p.ws + OFF_W1T) + (size_t)which * 256 * 4096; t.ld_dst = 4096; t.n0 = (r >> 5) * 128; t.k0 = (r & 31) * 128; return; }
    j -= J_W1;
    if (j < J_W2) { const int which = j >> 1, r = j & 1; const float* w = p.w2_k + (which ? (long long)(p.w2_v - p.w2_k) : 0ll);
        t.f = ColFn{w, nullptr, 0}; t.ld_src = 128; t.dst = (bf16_t*)(p.ws + OFF_W2T) + (size_t)which * 128 * 256; t.ld_dst = 256; t.n0 = 0; t.k0 = r * 128; return; }
    j -= J_W2;
    if (j < J_GU) { const int e = j >> 7, r = j & 127;
        const float* g0 = p.e_gate + (e < 64 ? (long long)e * 2048 * 512 : (long long)(p.s_gate - p.e_gate));
        const float* g1 = p.e_up + (e < 64 ? (long long)e * 2048 * 512 : (long long)(p.s_up - p.e_up));
        t.f = ColFn{g0, g1, 2}; t.ld_src = 512; t.dst = (bf16_t*)(p.ws + OFF_GUT) + (size_t)e * 1024 * 2048; t.ld_dst = 2048; t.n0 = (r >> 4) * 128; t.k0 = (r & 15) * 128; return; }
    j -= J_GU;
    { const int e = j >> 6, r = j & 63;
        const float* g0 = p.e_down + (e < 64 ? (long long)e * 512 * 2048 : (long long)(p.s_down - p.e_down));
        t.f = ColFn{g0, nullptr, 0}; t.ld_src = 2048; t.dst = (bf16_t*)(p.ws + OFF_DNT) + (size_t)e * 2048 * 512; t.ld_dst = 512; t.n0 = (r >> 2) * 128; t.k0 = (r & 3) * 128; }
}

constexpr int J_MOD = 192, J_B1 = 8;
__device__ __forceinline__ void phase_prologue(const Params& p, int bid, int nb, unsigned char* smem) {
    float* sf = (float*)smem;
    const int tid = opaque((int)threadIdx.x);
    for (int j = bid; j < J_MOD; j += nb) {
        float* sc = sf;
        float* red = sf + 4096;
        for (int i = tid; i < 4096; i += NTHR) sc[i] = silu_f(p.c[i]);
        __syncthreads();
        const int cg = tid & 15, kl = tid >> 4, j0 = j * 64 + cg * 4;
        float a0[4] = {0, 0, 0, 0}, a1[4] = {0, 0, 0, 0};
        for (int kb = 0; kb < 2048; kb += 256) {
            f32x4 w[8];
#pragma unroll
            for (int u = 0; u < 8; ++u) w[u] = *(const f32x4*)(p.w_ada + (size_t)(kb + 32 * u + kl) * 12288 + j0);
#pragma unroll
            for (int u = 0; u < 8; ++u) { const float c0 = sc[kb + 32 * u + kl], c1 = sc[2048 + kb + 32 * u + kl];
#pragma unroll
                for (int q = 0; q < 4; ++q) { a0[q] += c0 * w[u][q]; a1[q] += c1 * w[u][q]; } }
        }
#pragma unroll
        for (int q = 0; q < 4; ++q) { red[(kl * 16 + cg) * 8 + q] = a0[q]; red[(kl * 16 + cg) * 8 + 4 + q] = a1[q]; }
        __syncthreads();
        if (tid < 128) {
            const int b = tid >> 6, col = tid & 63, cg2 = col >> 2, q = col & 3;
            float s = 0.f;
            for (int k2 = 0; k2 < 32; ++k2) s += red[(k2 * 16 + cg2) * 8 + b * 4 + q];
            ((float*)(p.ws + OFF_MOD))[b * 12288 + j * 64 + col] = s + p.b_ada[j * 64 + col];
        }
        __syncthreads();
    }
    for (int j = (bid + nb - (J_MOD % nb)) % nb; j < J_B1; j += nb) {
        const int which = j >> 2, jb = j & 3;
        const float* pe = p.pe_k + (which ? (long long)(p.pe_v - p.pe_k) : 0ll);
        const float* w1 = p.w1_k + (which ? (long long)(p.w1_v - p.w1_k) : 0ll);
        const int col = tid & 63, kl = tid >> 6;
        float acc = 0.f;
#pragma unroll 8
        for (int kk = kl; kk < 4096; kk += 8) acc += pe[kk] * w1[(size_t)kk * 256 + jb * 64 + col];
        sf[kl * 64 + col] = acc;
        __syncthreads();
        if (tid < 64) { float s = 0.f; for (int k2 = 0; k2 < 8; ++k2) s += sf[k2 * 64 + tid]; ((float*)(p.ws + OFF_BIAS1))[which * 256 + jb * 64 + tid] = s; }
        __syncthreads();
    }
    { float* rwp = (float*)(p.ws + OFF_RWP);
      for (int i = bid * NTHR + tid; i < 2048 * 64; i += nb * NTHR) { const int k = i >> 6, c = i & 63; rwp[i] = p.router_w[(size_t)k * 64 + 16 * (c & 3) + (c >> 2)]; } }
    {
        unsigned* tile = (unsigned*)smem;
        int j = bid;
        TpJob cur; TileRegs rc;
        if (j < J_EARLY) { tp_decode(p, j, cur); tp_load(cur.f, cur.ld_src, cur.n0, cur.k0, tid, rc); }
        while (j < J_EARLY) {
            const int jn = j + nb;
            TpJob nxt; TileRegs rn;
            if (jn < J_EARLY) { tp_decode(p, jn, nxt); tp_load(nxt.f, nxt.ld_src, nxt.n0, nxt.k0, tid, rn); }
            tp_store(rc, cur.dst, cur.ld_dst, cur.n0, cur.k0, tid, tile);
            cur = nxt; rc = rn; j = jn;
        }
    }
}

__device__ __forceinline__ int ec_next_id(unsigned* qhead, LAS int* qs) {
    int nx = qs[3];
    if (nx >= qs[4]) { nx = J_EARLY + 8 * (int)__hip_atomic_fetch_add(qhead, 1u, __ATOMIC_RELAXED, __HIP_MEMORY_SCOPE_AGENT); qs[4] = nx + 8; }
    qs[3] = nx + 1;
    return nx;
}
__device__ __forceinline__ void phase_expert_convert(const Params& p, unsigned* qhead, unsigned char* smem, int budget = 1 << 30) {
    unsigned* tile = (unsigned*)smem; LAS int* qslot = (LAS int*)(dyn_smem_base() + LDS_BYTES_C - 128);
    const int tid = opaque((int)threadIdx.x);
    __syncthreads();
    if (tid == 0) { for (int i = 0; i < 3; ++i) qslot[i] = ec_next_id(qhead, qslot); }
    __syncthreads();
    int j0 = qslot[0], j1 = qslot[1], j2 = qslot[2];
    __syncthreads();
    TpJob t0, t1, t2; TileRegs r0, r1, r2;
    if (j0 < J_TP) { tp_decode(p, j0, t0); tp_load(t0.f, t0.ld_src, t0.n0, t0.k0, tid, r0); }
    if (j1 < J_TP) { tp_decode(p, j1, t1); tp_load(t1.f, t1.ld_src, t1.n0, t1.k0, tid, r1); }
    if (j2 < J_TP) { tp_decode(p, j2, t2); tp_load(t2.f, t2.ld_src, t2.n0, t2.k0, tid, r2); }
#define EC_STEP(jX, tX, rX) do { \
        if (tid == 0) qslot[0] = (--budget > 0) ? ec_next_id(qhead, qslot) : J_TP; \
        tp_store(rX, tX.dst, tX.ld_dst, tX.n0, tX.k0, tid, tile);                  \
        jX = qslot[0]; \
        LDS_BARRIER(); \
        if (jX < J_TP) { tp_decode(p, jX, tX); tp_load(tX.f, tX.ld_src, tX.n0, tX.k0, tid, rX); } } while (0)
    for (;;) {
        if (j0 >= J_TP) break; EC_STEP(j0, t0, r0);
        if (j1 >= J_TP) break; EC_STEP(j1, t1, r1);
        if (j2 >= J_TP) break; EC_STEP(j2, t2, r2);
    }
    if (j0 < J_TP) tp_store(r0, t0.dst, t0.ld_dst, t0.n0, t0.k0, tid, tile);
    if (j1 < J_TP) tp_store(r1, t1.dst, t1.ld_dst, t1.n0, t1.k0, tid, tile);
    if (j2 < J_TP) tp_store(r2, t2.dst, t2.ld_dst, t2.n0, t2.k0, tid, tile);
#undef EC_STEP
}

__device__ __forceinline__ bool expert_convert_one(const Params& p, unsigned* qhead, unsigned char* smem) {
    unsigned* tile = (unsigned*)smem; LAS int* qslot = (LAS int*)(dyn_smem_base() + LDS_BYTES_C - 128);
    const int tid = opaque((int)threadIdx.x);
    if (tid == 0) qslot[0] = ec_next_id(qhead, qslot);
    __syncthreads();
    const int j = qslot[0];
    __syncthreads();
    if (j >= J_TP) return false;
    TpJob cur; TileRegs rc;
    tp_decode(p, j, cur); tp_load(cur.f, cur.ld_src, cur.n0, cur.k0, tid, rc);
    tp_store(rc, cur.dst, cur.ld_dst, cur.n0, cur.k0, tid, tile);
    return true;
}
__device__ __forceinline__ void xcd_barrier_work(const XcdBarrier& b, const Params& p, unsigned* qhead, unsigned char* smem) {
    asm volatile("s_waitcnt vmcnt(0)" ::: "memory");
    __syncthreads();
    LAS unsigned* wf = (LAS unsigned*)(dyn_smem_base() + LDS_BYTES_C - 80);
    if (threadIdx.x == 0) {
        unsigned* bar = b.bar;
        __builtin_amdgcn_s_waitcnt(0);
        unsigned nloc = b.st[0], nx = b.st[1];
        if (nloc == 0u) { xcd_barrier_complete(bar, b.x, nloc, nx); b.st[0] = nloc; b.st[1] = nx; }
        const unsigned old = xb_add(&bar[XB_XSUB(b.x)], 1u);
        const unsigned gen = old / nloc;
        if (old + 1u == (gen + 1u) * nloc) {
            __builtin_amdgcn_fence(__ATOMIC_RELEASE, "agent");
            asm volatile("s_waitcnt vmcnt(0)" ::: "memory");
            const unsigned og = xb_add(&bar[XB_TOP], 1u);
            const unsigned tg = og / nx;
            if (og + 1u == (tg + 1u) * nx) xb_add(&bar[XB_TOPGEN], 1u);
            else XB_SPIN(xb_ld(&bar[XB_TOPGEN]) == tg, bar);
            __builtin_amdgcn_fence(__ATOMIC_ACQUIRE, "agent");
            xb_add(&bar[XB_XGEN(b.x)], 1u);
            asm volatile("s_waitcnt vmcnt(0)" ::: "memory");
            wf[0] = 1u;
        } else { wf[0] = 0u; wf[1] = gen; }
    }
    __syncthreads();
    if (wf[0] == 0u) {
        const unsigned gen = wf[1];
        bool more = true; unsigned spins = 0u;
        for (;;) {
            if (threadIdx.x == 0) { unsigned rel = (xb_ld(&b.bar[XB_XGEN(b.x)]) != gen) ? 1u : 0u;
                if (!rel && (++spins > XB_SPIN_CAP || ((spins & 255u) == 0u && xb_ld(&b.bar[XB_TMO])))) { if (spins > XB_SPIN_CAP) atomicAdd(&b.bar[XB_TMO], 1u); rel = 1u; }
                wf[2] = rel; }
            __syncthreads();
            const unsigned rel = wf[2];
            __syncthreads();
            if (rel) break;
            if (more) more = expert_convert_one(p, qhead, smem); else __builtin_amdgcn_s_sleep(4);
        }
        if (threadIdx.x == 0) {
            __builtin_amdgcn_fence(__ATOMIC_ACQUIRE, "agent");
            asm volatile("s_waitcnt vmcnt(0)" ::: "memory");
        }
    }
    __syncthreads();
}

__device__ __forceinline__ void phase_modulate(const float* xin, const float* nw, const float* mod, int shift_idx, int scale_idx, bf16_t* hout, int bid, int nb) {
    const int tid_ = opaque((int)threadIdx.x); const int lane0 = tid_ & 63, wv = tid_ >> 6;
    for (int row0 = (bid * 8 + wv) * 2; row0 < NTOK; row0 += nb * 16) {
        const int lane = opaque(lane0);
        f32x4 v[2][8]; float ss[2] = {0.f, 0.f};
#pragma unroll
        for (int rr = 0; rr < 2; ++rr) { const float* xr = xin + (size_t)(row0 + rr) * D;
#pragma unroll
            for (int c = 0; c < 8; ++c) v[rr][c] = *(const f32x4*)(xr + (c * 64 + lane) * 4); }
#pragma unroll
        for (int rr = 0; rr < 2; ++rr) {
#pragma unroll
            for (int c = 0; c < 8; ++c) ss[rr] += v[rr][c][0] * v[rr][c][0] + v[rr][c][1] * v[rr][c][1] + v[rr][c][2] * v[rr][c][2] + v[rr][c][3] * v[rr][c][3];
            ss[rr] = wave_sum(ss[rr]); }
        const int b = row0 / T;
        const float* sh = mod + b * 12288 + shift_idx * 2048; const float* sc = mod + b * 12288 + scale_idx * 2048;
        const float rstd0 = rsqrtf(ss[0] * (1.f / D) + 1e-6f), rstd1 = rsqrtf(ss[1] * (1.f / D) + 1e-6f);
#pragma unroll
        for (int c = 0; c < 8; ++c) { const int col = (c * 64 + lane) * 4;
            const f32x4 w = *(const f32x4*)(nw + col), s1 = *(const f32x4*)(sc + col), s0 = *(const f32x4*)(sh + col);
#pragma unroll
            for (int rr = 0; rr < 2; ++rr) { float o[4]; const float rs = rr ? rstd1 : rstd0;
#pragma unroll
                for (int q = 0; q < 4; ++q) o[q] = v[rr][c][q] * rs * w[q] * (1.f + s1[q]) + s0[q];
                uint2 pk; pk.x = pack2(o[0], o[1]); pk.y = pack2(o[2], o[3]);
                *(uint2*)(hout + (size_t)(row0 + rr) * D + col) = pk; } }
    }
}

struct ARowDirect { const bf16_t* A; int lda; __device__ __forceinline__ const bf16_t* ptr(int r, int k) const { return A + (size_t)r * lda + k; } };
struct ARowWin { const bf16_t* proj; int col0; __device__ __forceinline__ const bf16_t* ptr(int r, int k) const { const int b = r >> 9, kvh = (r >> 8) & 1; int c = r & 255; c = c < 255 ? c : 254;
        return proj + (size_t)(b * T + 16 * c + (k >> 7)) * PROJ_LD + col0 + kvh * 128 + (k & 127); } };
struct ARowGather { const bf16_t* A; int lda; const int* idx; int rlast; __device__ __forceinline__ const bf16_t* ptr(int r, int k) const { return A + (size_t)idx[r < rlast ? r : rlast] * lda + k; } };
struct BRowDirect { const bf16_t* Bt; int ldb; __device__ __forceinline__ const bf16_t* row(int n) const { return Bt + (size_t)n * ldb; } };
struct BRowGateUp { const bf16_t* Bt; int ldb;
    __device__ __forceinline__ const bf16_t* row(int n) const { const int tn = n >> 7, nl = n & 127, u = 64 * tn + 32 * (nl >> 6) + (nl & 31), nt = (nl >> 5) & 1;
        return Bt + (size_t)((u >> 7) * 256 + nt * 128 + (u & 127)) * ldb; } };

constexpr int GS = 72;
template <class AF, class BF, class Epi>
__device__ __forceinline__ void gemm_tile128(const AF& af, const BF& bf, int kbeg, int K, int m0, int n0, const Epi& epi, unsigned char* smem) {
    bf16_t* As = (bf16_t*)smem; bf16_t* Bs = As + 128 * GS;
    const int tid = opaque((int)threadIdx.x), lane = tid & 63, wv = tid >> 6, wm = wv & 3, wn = wv >> 2;
    const int r0 = tid >> 3, kc = (tid & 7) * 8 + kbeg;
    const bf16_t* bp0 = bf.row(n0 + r0) + kc; const bf16_t* bp1 = bf.row(n0 + r0 + 64) + kc;
    f32x16 acc0, acc1;
#pragma unroll
    for (int i = 0; i < 16; ++i) { acc0[i] = 0.f; acc1[i] = 0.f; }
    uint4 ra0 = *(const uint4*)af.ptr(m0 + r0, kc), ra1 = *(const uint4*)af.ptr(m0 + r0 + 64, kc), rb0 = *(const uint4*)bp0, rb1 = *(const uint4*)bp1;
    const int nk = K >> 6;
    const int aoff = (wm * 32 + (lane & 31)) * GS + (lane >> 5) * 8, boff = (wn * 64 + (lane & 31)) * GS + (lane >> 5) * 8;
    for (int kt = 0; kt < nk; ++kt) {
        __syncthreads();
        *(uint4*)(As + r0 * GS + (kc - kbeg)) = ra0; *(uint4*)(As + (r0 + 64) * GS + (kc - kbeg)) = ra1;
        *(uint4*)(Bs + r0 * GS + (kc - kbeg)) = rb0; *(uint4*)(Bs + (r0 + 64) * GS + (kc - kbeg)) = rb1;
        __syncthreads();
        if (kt + 1 < nk) { const int ko = (kt + 1) * 64; ra0 = *(const uint4*)af.ptr(m0 + r0, kc + ko); ra1 = *(const uint4*)af.ptr(m0 + r0 + 64, kc + ko); rb0 = *(const uint4*)(bp0 + ko); rb1 = *(const uint4*)(bp1 + ko); }
#pragma unroll
        for (int ks = 0; ks < 4; ++ks) {
            const bf16x8 a = *(const bf16x8*)(As + aoff + ks * 16);
            const bf16x8 b0 = *(const bf16x8*)(Bs + boff + ks * 16);
            const bf16x8 b1 = *(const bf16x8*)(Bs + boff + 32 * GS + ks * 16);
            acc0 = __builtin_amdgcn_mfma_f32_32x32x16_bf16(a, b0, acc0, 0, 0, 0);
            acc1 = __builtin_amdgcn_mfma_f32_32x32x16_bf16(a, b1, acc1, 0, 0, 0);
        }
    }
#pragma unroll
    for (int r = 0; r < 16; ++r) {
        const int row = m0 + wm * 32 + (r & 3) + 8 * (r >> 2) + 4 * (lane >> 5), col = n0 + wn * 64 + (lane & 31);
        epi(row, col, acc0[r], acc1[r]);
    }
    __syncthreads();
}

struct EpiProj { bf16_t* proj; float* small;
    __device__ __forceinline__ void st(int row, int col, float v) const { if (col < C_SMALL) proj[(size_t)row * PROJ_LD + col] = f2bf(v); else if (col < C_SMALL + 40) small[(size_t)row * 64 + (col - C_SMALL)] = v; }
    __device__ __forceinline__ void operator()(int row, int col, float v0, float v1) const { st(row, col, v0); st(row, col + 32, v1); } };
struct EpiHid { bf16_t* hid; const float* bias;
    __device__ __forceinline__ void operator()(int row, int col, float v0, float v1) const { hid[(size_t)row * 256 + col] = f2bf(silu_f(v0 + bias[col])); hid[(size_t)row * 256 + col + 32] = f2bf(silu_f(v1 + bias[col + 32])); } };
struct EpiKc { bf16_t* o;
    __device__ __forceinline__ void operator()(int row, int col, float v0, float v1) const { o[(size_t)row * 128 + col] = f2bf(v0); o[(size_t)row * 128 + col + 32] = f2bf(v1); } };
struct EpiOut { const float* x; const float* mod; float* x1;
    __device__ __forceinline__ void operator()(int row, int col, float v0, float v1) const { const float* g = mod + (row / T) * 12288 + 2 * 2048; const size_t o = (size_t)row * D + col;
        x1[o] = x[o] + g[col] * v0; x1[o + 32] = x[o + 32] + g[col + 32] * v1; } };
struct EpiAct { bf16_t* act; int rend;
    __device__ __forceinline__ void operator()(int row, int col, float v0, float v1) const { if (row < rend) { const int tn = col >> 7, nl = col & 127, u = 64 * tn + 32 * (nl >> 6) + (nl & 31);
        act[(size_t)row * EFF + u] = f2bf(silu_f(v0) * v1); } } };
struct EpiY { bf16_t* y; const float* roww; int rend;
    __device__ __forceinline__ void operator()(int row, int col, float v0, float v1) const { if (row < rend) { const float w = roww[row]; y[(size_t)row * D + col] = f2bf(v0 * w); y[(size_t)row * D + col + 32] = f2bf(v1 * w); } } };

template <class Epi>
__device__ __forceinline__ void phase_gemm_dense(const bf16_t* A, int lda, const bf16_t* Bt, int M, int N, int K, const Epi& epi, int bid, int nb, unsigned char* smem) {
    const int tm = M / 128, tn = N / 128;
    ARowDirect af{A, lda}; BRowDirect bf{Bt, K};
    for (int t = bid; t < tm * tn; t += nb) gemm_tile128(af, bf, 0, K, (t % tm) * 128, (t / tm) * 128, epi, smem);
}

constexpr int RAWS = 392, QS = 136, AS = 68;
__device__ __forceinline__ void phase_gdn_prep(const Params& p, int bid, int nb, unsigned char* smem) {
    bf16_t* raw = (bf16_t*)smem; float* sV = (float*)smem; float* sW = sV + 64 * 129;
    float* cw = (float*)(smem + 66048);
    bf16_t* sQ = (bf16_t*)(smem + 66048 + 6144); bf16_t* sK = sQ + 64 * QS;
    float* sA = (float*)(smem + 66048 + 6144 + 34816);
    float* s_beta = sA + 64 * AS; float* s_g = s_beta + 64; float* s_gc = s_g + 64; float* s_eg = s_gc + 64;
    const bf16_t* proj = (const bf16_t*)(p.ws + OFF_PROJ); const float* small = (const float*)(p.ws + OFF_SMALL);
    bf16_t* gnegw = (bf16_t*)(p.ws + OFF_GNEGW); bf16_t* gqd = (bf16_t*)(p.ws + OFF_GQD); bf16_t* gkdt = (bf16_t*)(p.ws + OFF_GKDT); bf16_t* gqk = (bf16_t*)(p.ws + OFF_GQK);
    bf16_t* gut = (bf16_t*)(p.ws + OFF_GUT2); float* egl = (float*)(p.ws + OFF_EGL);
    const int tid = opaque((int)threadIdx.x), lane = tid & 63, wv = tid >> 6;
    uint4 pre[7];
#define PREP_LOAD(jb) do { const int bh_ = (jb) >> 6, n_ = (jb) & 63, b_ = bh_ >> 3, h_ = bh_ & 7; \
        _Pragma("unroll") for (int i_ = 0; i_ < 7; ++i_) { const int id = tid + 512 * i_, r = id / 48, c = id - r * 48, tt = n_ * 64 - 3 + r; \
            pre[i_] = make_uint4(0u, 0u, 0u, 0u); \
            if (id < 67 * 48 && tt >= 0) pre[i_] = *(const uint4*)(proj + (size_t)(b_ * T + tt) * PROJ_LD + (c >> 4) * 1024 + h_ * 128 + (c & 15) * 8); } } while (0)
    if (bid < 1024) PREP_LOAD(bid);
    for (int job = bid; job < 1024; job += nb) {
        const int bh = job >> 6, n = job & 63, b = bh >> 3, h = bh & 7;
        const int row0 = b * T + n * 64;
#pragma unroll
        for (int i_ = 0; i_ < 7; ++i_) { const int id = tid + 512 * i_, r = id / 48, c = id - r * 48; if (id < 67 * 48) *(uint4*)(raw + r * RAWS + c * 8) = pre[i_]; }
        for (int id = tid; id < 4 * 384; id += NTHR) { const int i = id / 384, cc = id - i * 384; cw[id] = p.conv_w[i * 3072 + (cc >> 7) * 1024 + h * 128 + (cc & 127)]; }
        if (tid < 64) { const int row = row0 + tid; s_beta[tid] = sigmoid_f(small[(size_t)row * 64 + h]);
            s_g[tid] = -__expf(p.a_log[h]) * softplus_f(small[(size_t)row * 64 + 8 + h] + p.dt_bias[h]); }
        __syncthreads();
        if (tid == 0) { float s = 0.f; for (int t = 0; t < 64; ++t) { s += s_g[t]; s_gc[t] = s; } }
        float vkeep[2][8];
#pragma unroll
        for (int part = 0; part < 3; ++part)
#pragma unroll
            for (int it = 0; it < 2; ++it) {
                const int id = tid + 512 * it, ch = id & 15, t = id >> 4, cc = part * 128 + ch * 8;
                float acc[8];
#pragma unroll
                for (int q = 0; q < 8; ++q) acc[q] = 0.f;
#pragma unroll
                for (int i = 0; i < 4; ++i) { const uint4 rv = *(const uint4*)(raw + (t + i) * RAWS + cc); const f32x4 w0 = *(const f32x4*)(cw + i * 384 + cc), w1 = *(const f32x4*)(cw + i * 384 + cc + 4);
                    acc[0] += w0[0] * bf2f((bf16_t)(rv.x & 0xffff)); acc[1] += w0[1] * bf2f((bf16_t)(rv.x >> 16)); acc[2] += w0[2] * bf2f((bf16_t)(rv.y & 0xffff)); acc[3] += w0[3] * bf2f((bf16_t)(rv.y >> 16));
                    acc[4] += w1[0] * bf2f((bf16_t)(rv.z & 0xffff)); acc[5] += w1[1] * bf2f((bf16_t)(rv.z >> 16)); acc[6] += w1[2] * bf2f((bf16_t)(rv.w & 0xffff)); acc[7] += w1[3] * bf2f((bf16_t)(rv.w >> 16)); }
                float ss = 0.f;
#pragma unroll
                for (int q = 0; q < 8; ++q) { acc[q] = silu_f(acc[q]); ss += acc[q] * acc[q]; }
                if (part < 2) {
                    ss += __shfl_xor(ss, 1); ss += __shfl_xor(ss, 2); ss += __shfl_xor(ss, 4); ss += __shfl_xor(ss, 8);
                    const float rn = rsqrtf(ss + 1e-6f) * (part == 0 ? 0.08838834764831845f : 1.f);
                    uint4 o; o.x = pack2(acc[0] * rn, acc[1] * rn); o.y = pack2(acc[2] * rn, acc[3] * rn); o.z = pack2(acc[4] * rn, acc[5] * rn); o.w = pack2(acc[6] * rn, acc[7] * rn);
                    *(uint4*)((part == 0 ? sQ : sK) + t * QS + ch * 8) = o;
                } else {
#pragma unroll
                    for (int q = 0; q < 8; ++q) vkeep[it][q] = acc[q];
                }
            }
        __syncthreads();
        if (tid < 64) s_eg[tid] = __expf(s_gc[tid]);
#pragma unroll
        for (int it = 0; it < 2; ++it) { const int id = tid + 512 * it, ch = id & 15, t = id >> 4; const float bt = s_beta[t];
#pragma unroll
            for (int q = 0; q < 8; ++q) sV[t * 129 + ch * 8 + q] = vkeep[it][q] * bt; }
#pragma unroll
        for (int it = 0; it < 2; ++it) { const int id = tid + 512 * it, ch = id & 15, t = id >> 4; const float f = s_beta[t] * __expf(s_gc[t]);
            const uint4 kv = *(const uint4*)(sK + t * QS + ch * 8); float* wp = sW + t * 129 + ch * 8;
            wp[0] = bf2f((bf16_t)(kv.x & 0xffff)) * f; wp[1] = bf2f((bf16_t)(kv.x >> 16)) * f; wp[2] = bf2f((bf16_t)(kv.y & 0xffff)) * f; wp[3] = bf2f((bf16_t)(kv.y >> 16)) * f;
            wp[4] = bf2f((bf16_t)(kv.z & 0xffff)) * f; wp[5] = bf2f((bf16_t)(kv.z >> 16)) * f; wp[6] = bf2f((bf16_t)(kv.w & 0xffff)) * f; wp[7] = bf2f((bf16_t)(kv.w >> 16)) * f; }
        {
            const int lo_ = opaque(lane); const int prod = wv >> 2, ti = (wv >> 1) & 1, tj = wv & 1, kr = lo_ & 31, hh = lo_ >> 5;
            const bf16_t* X = prod ? sQ : sK;
            f32x16 acc;
#pragma unroll
            for (int r = 0; r < 16; ++r) acc[r] = 0.f;
#pragma unroll
            for (int s = 0; s < 8; ++s) { const bf16x8 av = *(const bf16x8*)(X + (32 * ti + kr) * QS + 16 * s + 8 * hh); const bf16x8 bv = *(const bf16x8*)(sK + (32 * tj + kr) * QS + 16 * s + 8 * hh);
                acc = MFMA32(av, bv, acc); }
            const int j = 32 * tj + kr; const float gcj = s_gc[j];
#pragma unroll
            for (int r = 0; r < 16; ++r) { const int i = 32 * ti + (r & 3) + 8 * (r >> 2) + 4 * hh;
                const float dec = (i >= j) ? __expf(s_gc[i] - gcj) : 0.f;
                if (prod == 0) sA[i * AS + j] = (i > j) ? s_beta[i] * acc[r] * dec : 0.f;
                else gqk[(size_t)job * 4096 + i * 64 + (j & 32) + perm32(j & 31)] = f2bf(acc[r] * dec); }
        }
        __syncthreads();
        if (job + nb < 1024) PREP_LOAD(job + nb);
        if (tid < 256) {
            float* colp = (tid < 128) ? (sV + tid) : (sW + (tid - 128));
            const float* sAo = sA + opaque(0);
            float x[64];
#pragma unroll
            for (int i = 0; i < 64; ++i) {
                float s = colp[i * 129];
#pragma unroll
                for (int j4 = 0; j4 < (i + 3) / 4; ++j4) { const f32x4 av = *(const f32x4*)(sAo + i * AS + 4 * j4);
#pragma unroll
                    for (int q = 0; q < 4; ++q) if (4 * j4 + q < i) s -= av[q] * x[4 * j4 + q]; }
                x[i] = s; colp[i * 129] = s;
                if ((i & 3) == 3) __builtin_amdgcn_sched_barrier(0);
            }
        }
        __syncthreads();
        const float glast = s_gc[63];
        if (tid < 256) {
            const int c = tid >> 2, s = tid & 3; unsigned o[16];
#pragma unroll
            for (int pp = 0; pp < 16; ++pp) { const int p0 = 2 * pp, j0 = p0 & 7, g0 = p0 >> 3, d0 = 16 * (j0 >> 2) + 4 * g0 + (j0 & 3);
                o[pp] = pack2(-sW[c * 129 + 32 * s + d0], -sW[c * 129 + 32 * s + d0 + 1]); }
            uint4* dp = (uint4*)(gnegw + (size_t)job * 8192 + c * 128 + 32 * s);
#pragma unroll
            for (int q = 0; q < 4; ++q) dp[q] = make_uint4(o[4 * q], o[4 * q + 1], o[4 * q + 2], o[4 * q + 3]);
        } else {
            const int t2 = tid - 256, c = t2 >> 2, s = t2 & 3; const float eg = s_eg[c]; unsigned o[16];
#pragma unroll
            for (int pp = 0; pp < 16; ++pp) { const int p0 = 2 * pp, j0 = p0 & 7, g0 = p0 >> 3, d0 = 16 * (j0 >> 2) + 4 * g0 + (j0 & 3);
                o[pp] = pack2(bf2f(sQ[c * QS + 32 * s + d0]) * eg, bf2f(sQ[c * QS + 32 * s + d0 + 1]) * eg); }
            uint4* dp = (uint4*)(gqd + (size_t)job * 8192 + c * 128 + 32 * s);
#pragma unroll
            for (int q = 0; q < 4; ++q) dp[q] = make_uint4(o[4 * q], o[4 * q + 1], o[4 * q + 2], o[4 * q + 3]);
        }
        if (tid < 256) {
            const int d = tid >> 1, s = tid & 1; unsigned o[16];
#pragma unroll
            for (int pp = 0; pp < 16; ++pp) { const int p0 = 2 * pp, j0 = p0 & 7, g0 = p0 >> 3, c0 = 32 * s + 16 * (j0 >> 2) + 4 * g0 + (j0 & 3);
                o[pp] = pack2(bf2f(sK[c0 * QS + d]) * __expf(glast - s_gc[c0]), bf2f(sK[(c0 + 1) * QS + d]) * __expf(glast - s_gc[c0 + 1])); }
            uint4* dp = (uint4*)(gkdt + (size_t)job * 8192 + d * 64 + 32 * s);
#pragma unroll
            for (int q = 0; q < 4; ++q) dp[q] = make_uint4(o[4 * q], o[4 * q + 1], o[4 * q + 2], o[4 * q + 3]);
        } else {
            const int t2 = tid - 256, d = t2 >> 1, s = t2 & 1; unsigned o[16];
#pragma unroll
            for (int pp = 0; pp < 16; ++pp) o[pp] = pack2(sV[(32 * s + 2 * pp) * 129 + d], sV[(32 * s + 2 * pp + 1) * 129 + d]);
            uint4* dp = (uint4*)(gut + (size_t)job * 8192 + d * 64 + 32 * s);
#pragma unroll
            for (int q = 0; q < 4; ++q) dp[q] = make_uint4(o[4 * q], o[4 * q + 1], o[4 * q + 2], o[4 * q + 3]);
        }
        if (tid == 0) egl[job] = __expf(glast);
        __syncthreads();
    }
#undef PREP_LOAD
}

constexpr int GW = 136, GK = 72, GO = 132;
constexpr int GU = 72;
constexpr int GSCAN_BUF = (64 * GW + 128 * GK + 128 * GU) * 2;
__device__ __forceinline__ void phase_gdn_scan(const Params& p, int bh, unsigned char* smem) {
    const bf16_t* gnegw = (const bf16_t*)(p.ws + OFF_GNEGW); const bf16_t* gkdt = (const bf16_t*)(p.ws + OFF_GKDT);
    const bf16_t* gut = (const bf16_t*)(p.ws + OFF_GUT2); const float* egl = (const float*)(p.ws + OFF_EGL);
    uint4* gsb = (uint4*)(p.ws + OFF_GSB); uint4* gvb = (uint4*)(p.ws + OFF_GVB);
    const int tid = opaque((int)threadIdx.x), lane = tid & 63, wv = tid >> 6, g = lane >> 4, c16 = lane & 15, e = wv * 16 + c16;
    const int r1 = tid >> 4, k1 = (tid & 15) * 8;
    const int r2 = tid >> 3, k2 = (tid & 7) * 8;
    uint4 Aw0, Aw1, Ak0, Ak1, Au0, Au1, Bw0, Bw1, Bk0, Bk1, Bu0, Bu1;
#define GDN_LOAD(X, job) do { const size_t o_ = (size_t)(job) * 8192; \
        X##w0 = *(const uint4*)(gnegw + o_ + r1 * 128 + k1); X##w1 = *(const uint4*)(gnegw + o_ + (r1 + 32) * 128 + k1); \
        X##k0 = *(const uint4*)(gkdt + o_ + r2 * 64 + k2); X##k1 = *(const uint4*)(gkdt + o_ + (r2 + 64) * 64 + k2); \
        X##u0 = *(const uint4*)(gut + o_ + r2 * 64 + k2); X##u1 = *(const uint4*)(gut + o_ + (r2 + 64) * 64 + k2); } while (0)
#define GDN_STORE(X, bufi) do { bf16_t* sWn_ = (bf16_t*)(smem + (bufi) * GSCAN_BUF); bf16_t* sKd_ = sWn_ + 64 * GW; bf16_t* sU_ = sKd_ + 128 * GK; \
        *(uint4*)(sWn_ + r1 * GW + k1) = X##w0; *(uint4*)(sWn_ + (r1 + 32) * GW + k1) = X##w1; \
        *(uint4*)(sKd_ + r2 * GK + k2) = X##k0; *(uint4*)(sKd_ + (r2 + 64) * GK + k2) = X##k1; \
        *(uint4*)(sU_ + r2 * GU + k2) = X##u0; *(uint4*)(sU_ + (r2 + 64) * GU + k2) = X##u1; } while (0)
    f32x4 S[8];
#pragma unroll
    for (int i = 0; i < 8; ++i) S[i] = (f32x4){0.f, 0.f, 0.f, 0.f};
    GDN_LOAD(A, bh * 64);
    GDN_STORE(A, 0);
    GDN_LOAD(B, bh * 64 + 1); GDN_LOAD(A, bh * 64 + 2);
    __syncthreads();
#define GDN_STEP(n, X) do { \
        const int job = bh * 64 + (n); \
        if ((n) + 1 < 64) { GDN_STORE(X, ((n) + 1) & 1); if ((n) + 3 < 64) GDN_LOAD(X, job + 3); } \
        const bf16_t* sWn = (const bf16_t*)(smem + ((n) & 1) * GSCAN_BUF); const bf16_t* sKd = sWn + 64 * GW; const bf16_t* sU = sKd + 128 * GK; \
        f32x4 vacc[4]; \
        _Pragma("unroll") for (int ct = 0; ct < 4; ++ct) { const uint2 uu = *(const uint2*)(sU + e * GU + 16 * ct + 4 * g); \
            vacc[ct] = (f32x4){bf2f((bf16_t)(uu.x & 0xffff)), bf2f((bf16_t)(uu.x >> 16)), bf2f((bf16_t)(uu.y & 0xffff)), bf2f((bf16_t)(uu.y >> 16))}; } \
        const float eg = egl[job]; \
        bf16x8 sB[4]; \
        _Pragma("unroll") for (int s = 0; s < 4; ++s) { const uint4 tq = make_uint4(pack2(S[2 * s][0], S[2 * s][1]), pack2(S[2 * s][2], S[2 * s][3]), \
            pack2(S[2 * s + 1][0], S[2 * s + 1][1]), pack2(S[2 * s + 1][2], S[2 * s + 1][3])); sB[s] = __builtin_bit_cast(bf16x8, tq); \
            gsb[((size_t)(job * 8 + wv) * 4 + s) * 64 + lane] = tq; } \
        _Pragma("unroll") for (int ct = 0; ct < 4; ++ct) _Pragma("unroll") for (int s = 0; s < 4; ++s) { \
                const bf16x8 aw = *(const bf16x8*)(sWn + (16 * ct + c16) * GW + 32 * s + 8 * g); \
                vacc[ct] = __builtin_amdgcn_mfma_f32_16x16x32_bf16(aw, sB[s], vacc[ct], 0, 0, 0); } \
        bf16x8 vB[2]; \
        _Pragma("unroll") for (int s = 0; s < 2; ++s) { const uint4 tq = make_uint4(pack2(vacc[2 * s][0], vacc[2 * s][1]), pack2(vacc[2 * s][2], vacc[2 * s][3]), \
            pack2(vacc[2 * s + 1][0], vacc[2 * s + 1][1]), pack2(vacc[2 * s + 1][2], vacc[2 * s + 1][3])); vB[s] = __builtin_bit_cast(bf16x8, tq); \
            gvb[((size_t)(job * 8 + wv) * 2 + s) * 64 + lane] = tq; } \
        _Pragma("unroll") for (int dt = 0; dt < 8; ++dt) { S[dt] *= eg; \
            _Pragma("unroll") for (int s = 0; s < 2; ++s) { \
                const bf16x8 a = *(const bf16x8*)(sKd + (16 * dt + c16) * GK + 32 * s + 8 * g); \
                S[dt] = __builtin_amdgcn_mfma_f32_16x16x32_bf16(a, vB[s], S[dt], 0, 0, 0); } } \
        LDS_BARRIER(); \
    } while (0)
    for (int n = 0; n < 64; n += 2) { GDN_STEP(n, B); GDN_STEP(n + 1, A); }
#undef GDN_LOAD
#undef GDN_STORE
#undef GDN_STEP
}

__device__ __forceinline__ void phase_gdn_out(const Params& p, int bid, int nb, unsigned char* smem) {
    bf16_t* sQd = (bf16_t*)smem; bf16_t* sQK = sQd + 64 * GW; bf16_t* sG = sQK + 64 * GK; float* sO = (float*)(sG + 64 * GW); float* sNW = sO + 64 * GO;
    const bf16_t* proj = (const bf16_t*)(p.ws + OFF_PROJ); const bf16_t* gqd = (const bf16_t*)(p.ws + OFF_GQD); const bf16_t* gqk = (const bf16_t*)(p.ws + OFF_GQK);
    const uint4* gsb = (const uint4*)(p.ws + OFF_GSB); const uint4* gvb = (const uint4*)(p.ws + OFF_GVB);
    bf16_t* ycat = (bf16_t*)(p.ws + OFF_YCAT);
    const int tid = opaque((int)threadIdx.x), lane = tid & 63, wv = tid >> 6, g = lane >> 4, c16 = lane & 15, e = wv * 16 + c16;
    const int r1 = tid >> 4, k1 = (tid & 15) * 8, r2 = tid >> 3, k2 = (tid & 7) * 8, ec = tid >> 3, ee = (tid & 7) * 16;
    if (tid < 128) sNW[tid] = p.gdn_norm_w[tid];
    for (int job = bid; job < 1024; job += nb) {
        const int bh = job >> 6, n = job & 63, b = bh >> 3, h = bh & 7;
        const size_t o_ = (size_t)job * 8192; const bf16_t* gp_ = proj + (size_t)(b * T + n * 64) * PROJ_LD + C_GATEG + h * 128;
        const uint4 q0 = *(const uint4*)(gqd + o_ + r1 * 128 + k1), q1 = *(const uint4*)(gqd + o_ + (r1 + 32) * 128 + k1), qk = *(const uint4*)(gqk + (size_t)job * 4096 + r2 * 64 + k2);
        const uint4 g0 = *(const uint4*)(gp_ + (size_t)r1 * PROJ_LD + k1), g1 = *(const uint4*)(gp_ + (size_t)(r1 + 32) * PROJ_LD + k1);
        bf16x8 sB[4], vB[2];
#pragma unroll
        for (int s = 0; s < 4; ++s) { const uint4 tq = gsb[((size_t)(job * 8 + wv) * 4 + s) * 64 + lane]; sB[s] = __builtin_bit_cast(bf16x8, tq); }
#pragma unroll
        for (int s = 0; s < 2; ++s) { const uint4 tq = gvb[((size_t)(job * 8 + wv) * 2 + s) * 64 + lane]; vB[s] = __builtin_bit_cast(bf16x8, tq); }
        __syncthreads();
        *(uint4*)(sQd + r1 * GW + k1) = q0; *(uint4*)(sQd + (r1 + 32) * GW + k1) = q1; *(uint4*)(sQK + r2 * GK + k2) = qk;
        *(uint4*)(sG + r1 * GW + k1) = g0; *(uint4*)(sG + (r1 + 32) * GW + k1) = g1;
        __syncthreads();
        f32x4 oacc[4];
#pragma unroll
        for (int ct = 0; ct < 4; ++ct) { oacc[ct] = (f32x4){0.f, 0.f, 0.f, 0.f};
#pragma unroll
            for (int s = 0; s < 4; ++s) { const bf16x8 aq = *(const bf16x8*)(sQd + (16 * ct + c16) * GW + 32 * s + 8 * g); oacc[ct] = __builtin_amdgcn_mfma_f32_16x16x32_bf16(aq, sB[s], oacc[ct], 0, 0, 0); }
#pragma unroll
            for (int s = 0; s < 2; ++s) { const bf16x8 a = *(const bf16x8*)(sQK + (16 * ct + c16) * GK + 32 * s + 8 * g); oacc[ct] = __builtin_amdgcn_mfma_f32_16x16x32_bf16(a, vB[s], oacc[ct], 0, 0, 0); } }
#pragma unroll
        for (int ct = 0; ct < 4; ++ct)
#pragma unroll
            for (int i = 0; i < 4; ++i) sO[(16 * ct + 4 * g + i) * GO + e] = oacc[ct][i];
        __syncthreads();
        {
            f32x4 o[4]; float ss = 0.f;
#pragma unroll
            for (int q = 0; q < 4; ++q) { o[q] = *(const f32x4*)(sO + ec * GO + ee + 4 * q); ss += o[q][0] * o[q][0] + o[q][1] * o[q][1] + o[q][2] * o[q][2] + o[q][3] * o[q][3]; }
            ss += __shfl_xor(ss, 1); ss += __shfl_xor(ss, 2); ss += __shfl_xor(ss, 4);
            const float rstd = rsqrtf(ss * (1.f / 128.f) + 1e-6f);
            const uint4 gq0 = *(const uint4*)(sG + ec * GW + ee), gq1 = *(const uint4*)(sG + ec * GW + ee + 8);
            unsigned yo[8];
#pragma unroll
            for (int q = 0; q < 8; ++q) { const unsigned gwq = (q == 0) ? gq0.x : (q == 1) ? gq0.y : (q == 2) ? gq0.z : (q == 3) ? gq0.w : (q == 4) ? gq1.x : (q == 5) ? gq1.y : (q == 6) ? gq1.z : gq1.w;
                const float ga = bf2f((bf16_t)(gwq & 0xffff)), gb = bf2f((bf16_t)(gwq >> 16)); const f32x4 nwv = *(const f32x4*)(sNW + ee + 4 * (q >> 1));
                const float y0 = o[q >> 1][(q & 1) * 2] * rstd * nwv[(q & 1) * 2] * silu_f(ga), y1 = o[q >> 1][(q & 1) * 2 + 1] * rstd * nwv[(q & 1) * 2 + 1] * silu_f(gb);
                yo[q] = pack2(y0, y1); }
            uint4* yp = (uint4*)(ycat + (size_t)(b * T + n * 64 + ec) * D + h * 128 + ee);
            yp[0] = make_uint4(yo[0], yo[1], yo[2], yo[3]); yp[1] = make_uint4(yo[4], yo[5], yo[6], yo[7]);
        }
    }
    __syncthreads();
}

constexpr int OS = 136;
constexpr int NSA_KV = 16384;
constexpr float NSA_SC2 = 0.08838834764831845f * 1.4426950408889634f;
typedef short s16x4 __attribute__((ext_vector_type(4)));

__device__ __forceinline__ void nsa_stage(const bf16_t* Kg, const bf16_t* Vg, int ld, unsigned char* smem, int buf) {
    const int tid = opaque((int)threadIdx.x), L = tid & 63, wvu = __builtin_amdgcn_readfirstlane(tid >> 6);
#pragma unroll
    for (int i = 0; i < 2; ++i) {
        const int row = 8 * wvu + 4 * i + (L >> 4), pos = L & 15, ch = pos ^ (((row & 3) << 2) | ((row >> 2) & 3));
        const size_t go = (size_t)row * ld + ch * 8;
        __builtin_amdgcn_global_load_lds((const unsigned*)(Kg + go), (LAS unsigned*)(smem + buf + wvu * 2048 + i * 1024), 16, 0, 0);
        __builtin_amdgcn_global_load_lds((const unsigned*)(Vg + go), (LAS unsigned*)(smem + buf + NSA_KV + wvu * 2048 + i * 1024), 16, 0, 0);
    }
}
__device__ __forceinline__ void nsa_scores(const unsigned char* sK, const bf16x8 (&bq)[8], f32x16& s0, f32x16& s1, int lane) {
    lane = opaque(lane); const int kr = lane & 31, h = lane >> 5, xr = ((kr & 3) << 2) | ((kr >> 2) & 3);
    const unsigned char* rp = sK + 256 * kr;
#pragma unroll
    for (int i = 0; i < 16; ++i) { s0[i] = 0.f; s1[i] = 0.f; }
#pragma unroll
    for (int s = 0; s < 8; ++s) {
        const int o = 16 * ((2 * s + h) ^ xr);
        const bf16x8 a0 = *(const bf16x8*)(rp + o);
        const bf16x8 a1 = *(const bf16x8*)(rp + 8192 + o);
        s0 = MFMA32(a0, bq[s], s0); s1 = MFMA32(a1, bq[s], s1);
        if (s & 1) __builtin_amdgcn_sched_barrier(0);
    }
}
__device__ __forceinline__ void nsa_pv_sel(const unsigned char* sV, const f32x16& p0, const f32x16& p1, f32x16 (&oacc)[4], unsigned pmask, int lane) {
    lane = opaque(lane); const int h = lane >> 5, blk = (lane >> 4) & 1, q = (lane & 15) >> 2, pp = lane & 3;
    const int base = 1024 * h + 256 * q + 8 * (pp & 1), lowv = 2 * blk + (pp >> 1);
#pragma unroll
    for (int s = 0; s < 4; ++s) { union { bf16x8 v; unsigned u[4]; } t;
#pragma unroll
        for (int j = 0; j < 4; ++j) { const int r = 8 * (s & 1) + 2 * j; t.u[j] = ((s < 2) ? pack2(p0[r], p0[r + 1]) : pack2(p1[r], p1[r + 1])) & pmask; }
#pragma unroll
        for (int dt = 0; dt < 4; ++dt) {
            union { bf16x8 v; s16x4 hlf[2]; } a;
#pragma unroll
            for (int tt = 0; tt < 2; ++tt) { const int ad = base + 4096 * s + 2048 * tt + 64 * (dt ^ q) + 16 * (lowv ^ (2 * tt + h));
                a.hlf[tt] = __builtin_amdgcn_ds_read_tr16_b64_v4i16((LAS s16x4*)(sV + ad)); }
            oacc[dt] = MFMA32(a.v, t.v, oacc[dt]);
        }
        __builtin_amdgcn_sched_barrier(0); }
}
__device__ __forceinline__ void nsa_pv(const unsigned char* sV, const f32x16& p0, const f32x16& p1, f32x16 (&oacc)[4], int lane) { nsa_pv_sel(sV, p0, p1, oacc, 0xffffffffu, lane); }
template <class VF>
__device__ __forceinline__ void nsa_tile_online(const unsigned char* sK, const unsigned char* sV, const bf16x8 (&bq)[8], f32x16 (&oacc)[4], float& m, float& l, const VF& valid, int lane) {
    const int h = opaque(lane) >> 5;
    f32x16 s0, s1;
    nsa_scores(sK, bq, s0, s1, lane);
    float mx = -1e30f;
#pragma unroll
    for (int r = 0; r < 16; ++r) { const int key = (r & 3) + 8 * (r >> 2) + 4 * h;
        s0[r] = valid(key) ? s0[r] * NSA_SC2 : -1e30f; s1[r] = valid(key + 32) ? s1[r] * NSA_SC2 : -1e30f;
        mx = fmaxf(mx, fmaxf(s0[r], s1[r])); }
    mx = fmaxf(mx, __shfl_xor(mx, 32));
    const float mn = fmaxf(m, mx);
    const float alpha = __builtin_amdgcn_exp2f(m - mn);
    float ps = 0.f;
#pragma unroll
    for (int r = 0; r < 16; ++r) {
        s0[r] = (s0[r] > -1e29f) ? __builtin_amdgcn_exp2f(s0[r] - mn) : 0.f;
        s1[r] = (s1[r] > -1e29f) ? __builtin_amdgcn_exp2f(s1[r] - mn) : 0.f;
        ps += s0[r] + s1[r]; }
    l = l * alpha + ps; m = mn;
#pragma unroll
    for (int dt = 0; dt < 4; ++dt)
#pragma unroll
        for (int r = 0; r < 16; ++r) oacc[dt][r] *= alpha;
    nsa_pv(sV, s0, s1, oacc, lane);
}
__device__ __forceinline__ void nsa_tile_fast(const unsigned char* sK, const unsigned char* sV, const bf16x8 (&bq)[8], f32x16 (&oacc)[4], float& m, float& l, bool rowsel, int lane) {
    f32x16 s0, s1;
    nsa_scores(sK, bq, s0, s1, lane);
    float mx = fmaxf(s0[0], s1[0]);
#pragma unroll
    for (int r = 1; r < 16; ++r) mx = fmaxf(mx, fmaxf(s0[r], s1[r]));
    mx = fmaxf(mx, __shfl_xor(mx, 32)) * NSA_SC2;
    if (__any(mx > m + 8.f)) {
        const float mn = (mx > m + 8.f) ? mx : m;
        const float alpha = __builtin_amdgcn_exp2f(m - mn);
        m = mn; l *= alpha;
#pragma unroll
        for (int dt = 0; dt < 4; ++dt)
#pragma unroll
            for (int r = 0; r < 16; ++r) oacc[dt][r] *= alpha;
    }
    float ps = 0.f;
#pragma unroll
    for (int r = 0; r < 16; ++r) { s0[r] = __builtin_amdgcn_exp2f(fmaf(s0[r], NSA_SC2, -m)); s1[r] = __builtin_amdgcn_exp2f(fmaf(s1[r], NSA_SC2, -m)); ps += s0[r] + s1[r]; }
    l += rowsel ? ps : 0.f;
    nsa_pv_sel(sV, s0, s1, oacc, rowsel ? 0xffffffffu : 0u, lane);
}
__device__ __forceinline__ void nsa_flush(bf16_t* yrow, const f32x16 (&oacc)[4], float f, bool first, int lane) {
    const int h = opaque(lane) >> 5;
#pragma unroll
    for (int dt = 0; dt < 4; ++dt)
#pragma unroll
        for (int rr = 0; rr < 4; ++rr) {
            bf16_t* dp = yrow + 32 * dt + 8 * rr + 4 * h;
            float v[4];
#pragma unroll
            for (int i = 0; i < 4; ++i) v[i] = oacc[dt][4 * rr + i] * f;
            if (!first) { const uint2 o = *(const uint2*)dp; v[0] += bf2f((bf16_t)(o.x & 0xffff)); v[1] += bf2f((bf16_t)(o.x >> 16)); v[2] += bf2f((bf16_t)(o.y & 0xffff)); v[3] += bf2f((bf16_t)(o.y >> 16)); }
            uint2 o; o.x = pack2(v[0], v[1]); o.y = pack2(v[2], v[3]); *(uint2*)dp = o;
        }
}

constexpr int NSA_BUF = 2 * NSA_KV;
#define NSA_WAIT(ahead) do { if ((ahead) >= 2) asm volatile("s_waitcnt vmcnt(8)" ::: "memory"); else if ((ahead) == 1) asm volatile("s_waitcnt vmcnt(4)" ::: "memory"); \
        else asm volatile("s_waitcnt vmcnt(0)" ::: "memory"); LDS_BARRIER(); } while (0)

__device__ __forceinline__ void nsa_job(const Params& p, int job, unsigned char* smem) {
    float* sImp = (float*)(smem + 4 * NSA_BUF); unsigned* sMask = (unsigned*)(sImp + 64 * 64);
    const bf16_t* proj = (const bf16_t*)(p.ws + OFF_PROJ); const float* small = (const float*)(p.ws + OFF_SMALL);
    const bf16_t* kc = (const bf16_t*)(p.ws + OFF_KVC); const bf16_t* vc = kc + 1024 * 128;
    const int tid = opaque((int)threadIdx.x), lane = tid & 63, wv = tid >> 6, h = lane >> 5, ql = lane & 31, tl = ql >> 2, gh = ql & 3;
    const int b = job >> 7, kvh = (job >> 6) & 1, qt = job & 63, t0 = qt * 64;
    const int tq = t0 + 8 * wv + tl;
    const size_t qrow = (size_t)(b * T + tq);
    const int head = kvh * 4 + gh;
    bf16_t* yrow = (bf16_t*)(p.ws + OFF_YCAT) + qrow * D + 1024 + head * 128;
    const int nct = (((t0 + 32) >> 4) >> 6) + 1;
    const bf16_t* kcb = kc + (size_t)(b * 512 + kvh * 256) * 128; const bf16_t* vcb = vc + (size_t)(b * 512 + kvh * 256) * 128;
    const bf16_t* pb = proj + (size_t)(b * T) * PROJ_LD + kvh * 128;
    const int jw0 = qt > 8 ? qt - 8 : 0;
    int nis, ncomp;
    __syncthreads();
    bf16x8 bq[8];
#pragma unroll
    for (int s = 0; s < 8; ++s) bq[s] = *(const bf16x8*)(proj + qrow * PROJ_LD + C_QN + head * 128 + 16 * s + 8 * h);
    f32x16 oacc[4];
    float m = -1e30f, l = 0.f;
    nis = 0; ncomp = 0;
    for (; nis < 3 && nis < nct; ++nis) nsa_stage(kcb + (size_t)nis * 64 * 128, vcb + (size_t)nis * 64 * 128, 128, smem, (nis & 3) * NSA_BUF);
    for (int ct = 0; ct < nct; ++ct) {
        NSA_WAIT(nis - ncomp - 1);
        const unsigned char* sK = smem + (ncomp & 3) * NSA_BUF; ++ncomp;
        if (nis < nct) { nsa_stage(kcb + (size_t)nis * 64 * 128, vcb + (size_t)nis * 64 * 128, 128, smem, (nis & 3) * NSA_BUF); ++nis; }
        f32x16 s0, s1; nsa_scores(sK, bq, s0, s1, lane);
        float mx = -1e30f; const int hh = opaque(lane) >> 5;
#pragma unroll
        for (int r = 0; r < 16; ++r) { const int c = ct * 64 + (r & 3) + 8 * (r >> 2) + 4 * hh;
            s0[r] = (c * 16 + 31 <= tq) ? s0[r] * NSA_SC2 : -1e30f; s1[r] = ((c + 32) * 16 + 31 <= tq) ? s1[r] * NSA_SC2 : -1e30f; mx = fmaxf(mx, fmaxf(s0[r], s1[r])); }
        mx = fmaxf(mx, __shfl_xor(mx, 32));
        const float mn = fmaxf(m, mx); float ps = 0.f;
#pragma unroll
        for (int r = 0; r < 16; ++r) { ps += (s0[r] > -1e29f) ? __builtin_amdgcn_exp2f(s0[r] - mn) : 0.f; ps += (s1[r] > -1e29f) ? __builtin_amdgcn_exp2f(s1[r] - mn) : 0.f; }
        l = l * __builtin_amdgcn_exp2f(m - mn) + ps; m = mn;
    }
    l += __shfl_xor(l, 32);
    const float linv = l > 0.f ? 1.f / l : 0.f;
#pragma unroll
    for (int dt = 0; dt < 4; ++dt)
#pragma unroll
        for (int r = 0; r < 16; ++r) oacc[dt][r] = 0.f;
    float carry = 0.f;
    LDS_BARRIER();
    nis = 0; ncomp = 0;
    for (; nis < 3 && nis < nct; ++nis) nsa_stage(kcb + (size_t)nis * 64 * 128, vcb + (size_t)nis * 64 * 128, 128, smem, (nis & 3) * NSA_BUF);
    for (int ct = 0; ct < 4; ++ct) {
        if (ct < nct) {
            NSA_WAIT(nis - ncomp - 1);
            const unsigned char* sK = smem + (ncomp & 3) * NSA_BUF; ++ncomp;
            if (nis < nct) { nsa_stage(kcb + (size_t)nis * 64 * 128, vcb + (size_t)nis * 64 * 128, 128, smem, (nis & 3) * NSA_BUF); ++nis; }
            f32x16 s0, s1; nsa_scores(sK, bq, s0, s1, lane); const int hh = opaque(lane) >> 5;
#pragma unroll
            for (int r = 0; r < 16; ++r) { const int c = ct * 64 + (r & 3) + 8 * (r >> 2) + 4 * hh;
                s0[r] = (c * 16 + 31 <= tq) ? __builtin_amdgcn_exp2f(s0[r] * NSA_SC2 - m) * linv : 0.f;
                s1[r] = ((c + 32) * 16 + 31 <= tq) ? __builtin_amdgcn_exp2f(s1[r] * NSA_SC2 - m) * linv : 0.f; }
#pragma unroll
            for (int mt = 0; mt < 2; ++mt)
#pragma unroll
                for (int rr = 0; rr < 4; ++rr) {
                    const float G = (mt ? s1[4 * rr] : s0[4 * rr]) + (mt ? s1[4 * rr + 1] : s0[4 * rr + 1]) + (mt ? s1[4 * rr + 2] : s0[4 * rr + 2]) + (mt ? s1[4 * rr + 3] : s0[4 * rr + 3]);
                    const float mine_last = mt ? s1[4 * rr + 3] : s0[4 * rr + 3];
                    const float prev_last = (rr > 0) ? (mt ? s1[4 * rr - 1] : s0[4 * rr - 1]) : (mt ? s0[15] : carry);
                    const float send = h ? prev_last : mine_last;
                    float v = G + __shfl_xor(send, 32);
                    v += __shfl_xor(v, 1); v += __shfl_xor(v, 2);
                    if (gh == 0) sImp[(wv * 8 + tl) * 64 + 16 * ct + 8 * mt + 2 * rr + h] = v;
                }
            carry = s1[15];
            nsa_pv(sK + NSA_KV, s0, s1, oacc, lane);
        } else {
            if (gh == 0) {
#pragma unroll
                for (int q = 0; q < 8; ++q) sImp[(wv * 8 + tl) * 64 + 16 * ct + 2 * q + h] = 0.f;
            }
        }
    }
    LDS_BARRIER();
    nis = 0; ncomp = 0;
    { int wi = jw0; for (; nis < 3 && wi <= qt; ++nis, ++wi) nsa_stage(pb + (size_t)(wi * 64) * PROJ_LD + C_KWIN, pb + (size_t)(wi * 64) * PROJ_LD + C_VWIN, PROJ_LD, smem, (nis & 3) * NSA_BUF); }
    nsa_flush(yrow, oacc, sigmoid_f(small[qrow * 64 + 16 + head]), true, lane);
    {
        const int lo_ = opaque(lane); const int tk = lo_ >> 3, sub = lo_ & 7;
        unsigned lo = 0u, hi = 0u;
        if (qt < 16) { lo = (1u << (qt + 1)) - 1u; }
        else {
            const float* ip = sImp + (wv * 8 + tk) * 64;
            unsigned bits = 0u;
            for (int i = 0; i < 8; ++i) { const int j = sub * 8 + i; const float v = ip[j]; int rank = 0;
                for (int j2 = 1; j2 <= qt - 2; ++j2) { const float v2 = ip[j2]; rank += (v2 > v || (v2 == v && j2 < j)) ? 1 : 0; }
                if (j >= 1 && j <= qt - 2 && rank < 13) bits |= 1u << i; }
            if (sub < 4) lo = bits << (8 * sub); else hi = bits << (8 * (sub - 4));
            lo |= __shfl_xor(lo, 1); hi |= __shfl_xor(hi, 1); lo |= __shfl_xor(lo, 2); hi |= __shfl_xor(hi, 2); lo |= __shfl_xor(lo, 4); hi |= __shfl_xor(hi, 4);
            lo |= 1u;
            if (qt < 32) lo |= 1u << qt; else hi |= 1u << (qt - 32);
            if (qt - 1 < 32) lo |= 1u << (qt - 1); else hi |= 1u << (qt - 33);
        }
        if (sub == 0) { sMask[(wv * 8 + tk) * 2] = lo; sMask[(wv * 8 + tk) * 2 + 1] = hi; }
    }
    LDS_BARRIER();
    const unsigned long long mymask = (unsigned long long)sMask[(wv * 8 + tl) * 2] | ((unsigned long long)sMask[(wv * 8 + tl) * 2 + 1] << 32);
    unsigned long long un;
    { unsigned lo = sMask[lane * 2], hi = sMask[lane * 2 + 1];
#pragma unroll
      for (int o = 32; o > 0; o >>= 1) { lo |= __shfl_xor(lo, o); hi |= __shfl_xor(hi, o); }
      un = (unsigned long long)(unsigned)__builtin_amdgcn_readfirstlane((int)lo) | ((unsigned long long)(unsigned)__builtin_amdgcn_readfirstlane((int)hi) << 32); }
#pragma unroll
    for (int dt = 0; dt < 4; ++dt)
#pragma unroll
        for (int r = 0; r < 16; ++r) oacc[dt][r] = 0.f;
    m = -1e30f; l = 0.f;
    {
        int wi = jw0 + nis;
        for (int j = jw0; j <= qt; ++j) {
            NSA_WAIT(nis - ncomp - 1);
            const unsigned char* sK = smem + (ncomp & 3) * NSA_BUF; ++ncomp;
            if (wi <= qt) { nsa_stage(pb + (size_t)(wi * 64) * PROJ_LD + C_KWIN, pb + (size_t)(wi * 64) * PROJ_LD + C_VWIN, PROJ_LD, smem, (nis & 3) * NSA_BUF); ++nis; ++wi; }
            const int kbase = j * 64;
            if (j < qt && j >= qt - 7) nsa_tile_fast(sK, sK + NSA_KV, bq, oacc, m, l, true, lane);
            else nsa_tile_online(sK, sK + NSA_KV, bq, oacc, m, l, [&](int key) { const int kp = kbase + key; return kp <= tq && kp > tq - 512; }, lane);
        }
    }
    LDS_BARRIER();
    nis = 0; ncomp = 0;
    unsigned long long irem = un >> 1; int ij = 0; bool imore = true;
    for (; nis < 3 && imore; ++nis) {
        nsa_stage(pb + (size_t)(ij * 64) * PROJ_LD + C_KSLC, pb + (size_t)(ij * 64) * PROJ_LD + C_VSLC, PROJ_LD, smem, (nis & 3) * NSA_BUF);
        if (irem == 0ull) imore = false; else { const int z = __builtin_ctzll(irem); ij += 1 + z; irem = (z >= 63) ? 0ull : (irem >> (z + 1)); } }
    { const float lt = l + __shfl_xor(l, 32); nsa_flush(yrow, oacc, lt > 0.f ? sigmoid_f(small[qrow * 64 + 32 + head]) / lt : 0.f, false, lane); }
#pragma unroll
    for (int dt = 0; dt < 4; ++dt)
#pragma unroll
        for (int r = 0; r < 16; ++r) oacc[dt][r] = 0.f;
    m = -1e30f; l = 0.f;
    {
        unsigned long long rem = un >> 1; int j = 0;
        for (;;) {
            NSA_WAIT(nis - ncomp - 1);
            const unsigned char* sK = smem + (ncomp & 3) * NSA_BUF; ++ncomp;
            if (imore) { nsa_stage(pb + (size_t)(ij * 64) * PROJ_LD + C_KSLC, pb + (size_t)(ij * 64) * PROJ_LD + C_VSLC, PROJ_LD, smem, (nis & 3) * NSA_BUF); ++nis;
                if (irem == 0ull) imore = false; else { const int z = __builtin_ctzll(irem); ij += 1 + z; irem = (z >= 63) ? 0ull : (irem >> (z + 1)); } }
            const bool selj = (mymask >> j) & 1ull; const int kbase = j * 64;
            if (j < qt) nsa_tile_fast(sK, sK + NSA_KV, bq, oacc, m, l, selj, lane);
            else nsa_tile_online(sK, sK + NSA_KV, bq, oacc, m, l, [&](int key) { return selj && (kbase + key <= tq); }, lane);
            if (rem == 0ull) break;
            const int z = __builtin_ctzll(rem); j += 1 + z; rem = (z >= 63) ? 0ull : (rem >> (z + 1));
        }
    }
    { const float lt = l + __shfl_xor(l, 32); nsa_flush(yrow, oacc, lt > 0.f ? sigmoid_f(small[qrow * 64 + 24 + head]) / lt : 0.f, false, lane); }
}

constexpr size_t OFF_CPART = OFF_FLAT;
struct EpiPart { float* o; __device__ __forceinline__ void operator()(int row, int col, float v0, float v1) const { o[(size_t)row * 256 + col] = v0; o[(size_t)row * 256 + col + 32] = v1; } };
__device__ __forceinline__ void phase_cmp1(const Params& p, int bid, int nb, unsigned char* smem) {
    for (int j = bid; j < 256; j += nb) {
        const int ks = j & 7, nt = (j >> 3) & 1, mt = (j >> 4) & 7, which = j >> 7;
        ARowWin af{(const bf16_t*)(p.ws + OFF_PROJ), which ? C_VCMP : C_KCMP}; BRowDirect bf{(const bf16_t*)(p.ws + OFF_W1T) + (size_t)which * 256 * 4096, 4096};
        EpiPart e{(float*)(p.ws + OFF_CPART) + (size_t)(ks * 2 + which) * 1024 * 256};
        gemm_tile128(af, bf, ks * 512, 512, mt * 128, nt * 128, e, smem);
    }
}
constexpr int HS = 264;
__device__ __forceinline__ void phase_cmp2(const Params& p, int bid, int nb, unsigned char* smem) {
    bf16_t* sH = (bf16_t*)smem;
    const int tid = opaque((int)threadIdx.x), lane = tid & 63, wv = tid >> 6;
    for (int j = bid; j < 64; j += nb) {
        const int which = j >> 5, r0 = (j & 31) * 32;
        const float* part = (const float*)(p.ws + OFF_CPART) + (size_t)which * 1024 * 256; const float* bias = (const float*)(p.ws + OFF_BIAS1) + which * 256;
#pragma unroll
        for (int it = 0; it < 4; ++it) { const int id = tid + 512 * it, r = id >> 6, c4 = (id & 63) * 4;
            f32x4 s = *(const f32x4*)(bias + c4);
#pragma unroll
            for (int ks = 0; ks < 8; ++ks) s += *(const f32x4*)(part + (size_t)ks * 2 * 1024 * 256 + (size_t)(r0 + r) * 256 + c4);
            uint2 o; o.x = pack2(silu_f(s[0]), silu_f(s[1])); o.y = pack2(silu_f(s[2]), silu_f(s[3]));
            *(uint2*)(sH + r * HS + c4) = o; }
        __syncthreads();
        if (wv < 4) {
            const bf16_t* w2 = (const bf16_t*)(p.ws + OFF_W2T) + (size_t)which * 128 * 256;
            f32x16 acc;
#pragma unroll
            for (int r = 0; r < 16; ++r) acc[r] = 0.f;
#pragma unroll
            for (int s = 0; s < 16; ++s) { const bf16x8 av = *(const bf16x8*)(sH + (lane & 31) * HS + 16 * s + 8 * (lane >> 5));
                const bf16x8 bv = *(const bf16x8*)(w2 + (size_t)(32 * wv + (lane & 31)) * 256 + 16 * s + 8 * (lane >> 5));
                acc = MFMA32(av, bv, acc); }
            bf16_t* o = (bf16_t*)(p.ws + OFF_KVC) + (size_t)which * 1024 * 128;
#pragma unroll
            for (int r = 0; r < 16; ++r) o[(size_t)(r0 + (r & 3) + 8 * (r >> 2) + 4 * (lane >> 5)) * 128 + 32 * wv + (lane & 31)] = f2bf(acc[r]);
        }
        __syncthreads();
    }
}

constexpr int SHS = 2052;
__device__ __forceinline__ void phase_router(const Params& p, int bid, int nb, unsigned char* smem, int cnt_off = 0) {
    float* sh = (float*)smem;
    const float* x1 = (const float*)(p.ws + OFF_X1); const float* mod = (const float*)(p.ws + OFF_MOD);
    bf16_t* h2 = (bf16_t*)(p.ws + OFF_H);
    int* tkidx = (int*)(p.ws + OFF_TKIDX); float* tkw = (float*)(p.ws + OFF_TKW); int* slot = (int*)(p.ws + OFF_SLOT);
    unsigned* cnt = (unsigned*)(p.ws + OFF_CTRL) + CW_CNT + cnt_off;
    const int tid = opaque((int)threadIdx.x), lane = tid & 63, wv = tid >> 6;
    for (int batch = bid; batch < NTOK / 16; batch += nb) {
        const int r0 = batch * 16;
#pragma unroll
        for (int rr = 0; rr < 2; ++rr) {
            const int lr = wv * 2 + rr, row = r0 + lr, b = row / T;
            const float* xr = x1 + (size_t)row * D;
            f32x4 v[8]; float ss = 0.f;
#pragma unroll
            for (int c = 0; c < 8; ++c) { v[c] = *(const f32x4*)(xr + (c * 64 + lane) * 4); ss += v[c][0] * v[c][0] + v[c][1] * v[c][1] + v[c][2] * v[c][2] + v[c][3] * v[c][3]; }
            ss = wave_sum(ss);
            const float rstd = rsqrtf(ss * (1.f / D) + 1e-6f);
            const float* shf = mod + b * 12288 + 3 * 2048; const float* sc = mod + b * 12288 + 4 * 2048;
#pragma unroll
            for (int c = 0; c < 8; ++c) { const int col = (c * 64 + lane) * 4;
                const f32x4 w = *(const f32x4*)(p.norm_ffn_w + col), s1 = *(const f32x4*)(sc + col), s0 = *(const f32x4*)(shf + col);
                f32x4 o;
#pragma unroll
                for (int q = 0; q < 4; ++q) o[q] = v[c][q] * rstd * w[q] * (1.f + s1[q]) + s0[q];
                *(f32x4*)(sh + lr * SHS + col) = o;
                uint2 pk; pk.x = pack2(o[0], o[1]); pk.y = pack2(o[2], o[3]);
                *(uint2*)(h2 + (size_t)row * D + col) = pk; }
        }
        __syncthreads();
        f32x4 acc[4];
#pragma unroll
        for (int nt = 0; nt < 4; ++nt) acc[nt] = (f32x4){0.f, 0.f, 0.f, 0.f};
        {
            const float* ap = sh + (lane & 15) * SHS + 256 * wv + (lane >> 4);
            const float* bp = (const float*)(p.ws + OFF_RWP) + (size_t)(256 * wv + (lane >> 4)) * 64 + 4 * (lane & 15);
#pragma unroll 8
            for (int s = 0; s < 64; ++s) {
                const float av = ap[4 * s];
                const f32x4 bv = *(const f32x4*)(bp + (size_t)s * 256);
#pragma unroll
                for (int nt = 0; nt < 4; ++nt) acc[nt] = __builtin_amdgcn_mfma_f32_16x16x4f32(av, bv[nt], acc[nt], 0, 0, 0);
            }
        }
        __syncthreads();
#pragma unroll
        for (int nt = 0; nt < 4; ++nt)
#pragma unroll
            for (int i = 0; i < 4; ++i) sh[(wv * 16 + 4 * (lane >> 4) + i) * 64 + 16 * nt + (lane & 15)] = acc[nt][i];
        __syncthreads();
        const float bias = p.router_bias[lane];
        unsigned* lcnt = (unsigned*)(sh + 8 * 16 * 64);
        if (tid < 64) lcnt[tid] = 0u;
        __syncthreads();
        int rnk[2]; unsigned loc[2];
#pragma unroll
        for (int rr = 0; rr < 2; ++rr) {
            const int lr = wv * 2 + rr, row = r0 + lr;
            float lg = 0.f;
#pragma unroll
            for (int w = 0; w < 8; ++w) lg += sh[(w * 16 + lr) * 64 + lane];
            const float score = sigmoid_f(lg), key = score + bias;
            int rank = 0;
            for (int j = 0; j < 64; ++j) { const float kj = __shfl(key, j); rank += (kj > key || (kj == key && j < lane)) ? 1 : 0; }
            const bool sel = rank < 8;
            const float ssum = wave_sum(sel ? score : 0.f);
            rnk[rr] = sel ? rank : -1; loc[rr] = 0u;
            if (sel) { tkidx[row * 8 + rank] = lane; tkw[row * 8 + rank] = score / ssum * 2.5f; loc[rr] = atomicAdd(&lcnt[lane], 1u); }
        }
        __syncthreads();
        if (tid < 64) lcnt[64 + tid] = atomicAdd(&cnt[tid], lcnt[tid]);
        __syncthreads();
#pragma unroll
        for (int rr = 0; rr < 2; ++rr) if (rnk[rr] >= 0) slot[(r0 + wv * 2 + rr) * 8 + rnk[rr]] = (int)(lcnt[64 + lane] + loc[rr]);
        __syncthreads();
    }
}

__device__ __forceinline__ void moe_offsets(const Params& p, int* offs) {
    if (opaque((int)threadIdx.x) == 0) { const unsigned* cnt = (const unsigned*)(p.ws + OFF_CTRL) + CW_CNT; int s = 0;
        for (int e = 0; e < 64; ++e) { offs[e] = s; s += (int)cnt[e]; }
        offs[64] = s; offs[65] = s + NTOK; }
    __syncthreads();
}
__device__ __forceinline__ void phase_scatter(const Params& p, int bid, int nb, unsigned char* smem) {
    int* offs = (int*)smem; moe_offsets(p, offs);
    const int* tkidx = (const int*)(p.ws + OFF_TKIDX); const float* tkw = (const float*)(p.ws + OFF_TKW); const int* slot = (const int*)(p.ws + OFF_SLOT);
    int* pos = (int*)(p.ws + OFF_POS); int* stok = (int*)(p.ws + OFF_STOK); float* roww = (float*)(p.ws + OFF_ROWW);
    const int tid = opaque((int)threadIdx.x);
    for (int i = bid * NTHR + tid; i < NTOK * 8; i += nb * NTHR) {
        const int e = tkidx[i], ps = offs[e] + slot[i];
        pos[i] = ps; stok[ps] = i >> 3; roww[ps] = tkw[i];
    }
    for (int t = bid * NTHR + tid; t < NTOK; t += nb * NTHR) { stok[NTOK * 8 + t] = t; roww[NTOK * 8 + t] = 1.f; }
}

__device__ __forceinline__ void phase_moe_gemm(const Params& p, int which, int bid, int nb, unsigned char* smem) {
    int* offs = (int*)(smem + 2 * 128 * GS * 2); int* tst = offs + 72;
    moe_offsets(p, offs);
    const int ntn = which ? 16 : 8;
    if (opaque((int)threadIdx.x) == 0) { int s = 0; for (int e = 0; e < 65; ++e) { tst[e] = s; s += ((offs[e + 1] - offs[e] + 127) >> 7) * ntn; } tst[65] = s; }
    __syncthreads();
    const int total = tst[65];
    const bf16_t* h2 = (const bf16_t*)(p.ws + OFF_H); bf16_t* act = (bf16_t*)(p.ws + OFF_ACT); bf16_t* y = (bf16_t*)(p.ws + OFF_Y);
    const int* stok = (const int*)(p.ws + OFF_STOK); const float* roww = (const float*)(p.ws + OFF_ROWW);
    for (int t = bid; t < total; t += nb) {
        int e = 0; while (t >= tst[e + 1]) ++e;
        const int loc = t - tst[e], mt = (offs[e + 1] - offs[e] + 127) >> 7, m0 = offs[e] + (loc % mt) * 128, n0 = (loc / mt) * 128;
        if (which == 0) {
            ARowGather af{h2, D, stok, offs[e + 1] - 1}; BRowGateUp bf{(const bf16_t*)(p.ws + OFF_GUT) + (size_t)e * 1024 * 2048, 2048}; EpiAct epi{act, offs[e + 1]};
            gemm_tile128(af, bf, 0, 2048, m0, n0, epi, smem);
        } else {
            ARowDirect af{act, EFF}; BRowDirect bf{(const bf16_t*)(p.ws + OFF_DNT) + (size_t)e * 2048 * 512, 512}; EpiY epi{y, roww, offs[e + 1]};
            gemm_tile128(af, bf, 0, 512, m0, n0, epi, smem);
        }
    }
}

__device__ __forceinline__ void phase_final(const Params& p, int bid, int nb, unsigned char* smem) {
    const float* x1 = (const float*)(p.ws + OFF_X1); const float* mod = (const float*)(p.ws + OFF_MOD);
    const bf16_t* y = (const bf16_t*)(p.ws + OFF_Y); const int* pos = (const int*)(p.ws + OFF_POS);
    const int tid_ = opaque((int)threadIdx.x); const int lane = tid_ & 63, wv = tid_ >> 6;
    float* srow = (float*)smem + wv * 2048;
    for (int row = bid * 8 + wv; row < NTOK; row += nb * 8) {
        const int b = row / T;
        const float* gm = mod + b * 12288 + 5 * 2048;
        const int* prow = pos + row * 8; const float* wrow = (const float*)(p.ws + OFF_TKW) + row * 8;
        float ss = 0.f;
#pragma unroll 4
        for (int c = 0; c < 8; ++c) { const int col = (c * 64 + lane) * 4;
            float acc[4] = {0.f, 0.f, 0.f, 0.f};
#pragma unroll
            for (int k = 0; k < 9; ++k) { const int pr = (k < 8) ? prow[k] : (NTOK * 8 + row); const float wk = (k < 8) ? wrow[k] : 1.f; const uint2 u = *(const uint2*)(y + (size_t)pr * D + col);
                acc[0] += wk * bf2f((bf16_t)(u.x & 0xffff)); acc[1] += wk * bf2f((bf16_t)(u.x >> 16)); acc[2] += wk * bf2f((bf16_t)(u.y & 0xffff)); acc[3] += wk * bf2f((bf16_t)(u.y >> 16)); }
            const f32x4 xv = *(const f32x4*)(x1 + (size_t)row * D + col), g = *(const f32x4*)(gm + col);
            f32x4 v;
#pragma unroll
            for (int q = 0; q < 4; ++q) { v[q] = xv[q] + g[q] * acc[q]; ss += v[q] * v[q]; }
            *(f32x4*)(srow + col) = v; }
        ss = wave_sum(ss);
        const float rstd = rsqrtf(ss * (1.f / D) + 1e-6f);
#pragma unroll 1
        for (int c = 0; c < 8; ++c) { const int col = (c * 64 + lane) * 4; const f32x4 w = *(const f32x4*)(p.norm_final_w + col); const f32x4 v = *(const f32x4*)(srow + col);
            f32x4 o;
#pragma unroll
            for (int q = 0; q < 4; ++q) o[q] = v[q] * rstd * w[q];
            *(f32x4*)(p.out + (size_t)row * D + col) = o; }
    }
}

namespace g8 {
#define G8_LAS __attribute__((address_space(3)))
typedef unsigned u32x4 __attribute__((ext_vector_type(4)));
constexpr int BM = 256, BK = 64, HALF = 128, HTB = HALF * BK * 2, STAGE_BYTES = 8 * HTB;
__device__ __forceinline__ int lds_byte(int r, int c) { const int st = (r >> 4) * 2 + (c >> 5), rr = r & 15, cc = c & 31, ob = rr * 64 + cc * 2; return st * 1024 + (ob ^ (((ob >> 9) & 1) << 5)); }
__device__ __forceinline__ void stage_rc(int b, int& R, int& C) { const int st = b / 1024, sb = b % 1024, swz = sb ^ (((sb >> 9) & 1) << 5); R = (st >> 1) * 16 + swz / 64; C = (st & 1) * 32 + (swz % 64) / 2; }
__device__ __forceinline__ int perm32r(int rho) { const int n = rho >> 4, i = rho & 15; return 8 * (i >> 2) + 4 * n + (i & 3); }
__device__ __forceinline__ unsigned cvt_pk_bf16(float lo, float hi) { return pack2(lo, hi); }

struct Unit { int m0, pn, rend, e; };

struct DenseSched { int nM, nN, nwg, G, c;
    __device__ void init(int M, int N, int G_, int c_) { nM = M / BM; nN = N / BM; nwg = nM * nN; G = G_; c = c_; }
    __device__ bool next(int i, Unit& u) const {
        const long L = (long)i * G + c; if (L >= nwg) return false;
        int wgid = (int)L; { const int q = nwg / 8, r = nwg % 8, xcd = wgid % 8, off = wgid / 8; wgid = (xcd < r ? xcd * (q + 1) : r * (q + 1) + (xcd - r) * q) + off; }
        const int nig = 8 * nN, gid = wgid / nig, fm = gid * 8, gsz = (nM - fm) < 8 ? (nM - fm) : 8;
        u.m0 = (fm + ((wgid % nig) % gsz)) * BM; u.pn = (wgid % nig) / gsz; u.rend = 0x7fffffff; u.e = 0; return true; } };
struct MoeSched { const G8_LAS int* tst; const G8_LAS int* offs; int G, c; mutable int ehint; int ntn;
    __device__ bool next(int i, Unit& u) const {
        const int nwg = tst[65]; const int L0 = i * G + c; if (L0 >= nwg) return false;
        int L; { const int q = nwg / 8, r = nwg % 8, xcd = L0 % 8, off = L0 / 8; L = (xcd < r ? xcd * (q + 1) : r * (q + 1) + (xcd - r) * q) + off; }
        int e = (L >= tst[ehint]) ? ehint : 0; while (L >= tst[e + 1]) ++e; ehint = e;
        const int loc = L - tst[e], mt = (offs[e + 1] - offs[e] + 255) >> 8;
        (void)mt; u.m0 = offs[e] + (loc / ntn) * BM; u.pn = loc % ntn; u.rend = offs[e + 1]; u.e = e; return true; } };
struct ADirect { static constexpr bool LOADS = false; unsigned K2; __device__ __forceinline__ unsigned off(const Unit& u, int r) const { return (unsigned)(u.m0 + r) * K2; } };
struct AGather { static constexpr bool LOADS = true; const int* idx; unsigned K2; __device__ __forceinline__ unsigned off(const Unit& u, int r) const { int rr = u.m0 + r; rr = rr < u.rend ? rr : u.rend - 1; return (unsigned)idx[rr] * K2; } };
struct BDense { const char* Bt; size_t tstep; __device__ __forceinline__ const char* base(const Unit& u) const { return Bt + (size_t)u.pn * tstep; } };
struct BGroup { const char* Bt; size_t tstep, estride; __device__ __forceinline__ const char* base(const Unit& u) const { return Bt + (size_t)u.e * estride + (size_t)u.pn * tstep; } };

struct EpiProj8 { static constexpr bool PERM = true; bf16_t* proj; float* small;
    __device__ __forceinline__ void operator()(const f32x4 (&acc)[2][2][4][2], const Unit& u, int wr, int wc, int fr, int fq) const {
#pragma unroll
        for (int ai = 0; ai < 2; ++ai)
#pragma unroll
            for (int m = 0; m < 4; ++m) { const int row = u.m0 + ai * HALF + wr * 64 + m * 16 + fr;
#pragma unroll
                for (int bj = 0; bj < 2; ++bj) { const int col = u.pn * BM + bj * HALF + wc * 32 + 8 * fq; const f32x4 v0 = acc[ai][bj][m][0], v1 = acc[ai][bj][m][1];
                    if (col < C_SMALL) { u32x4 w; w.x = cvt_pk_bf16(v0[0], v0[1]); w.y = cvt_pk_bf16(v0[2], v0[3]); w.z = cvt_pk_bf16(v1[0], v1[1]); w.w = cvt_pk_bf16(v1[2], v1[3]);
                        *(u32x4*)(proj + (size_t)row * PROJ_LD + col) = w; }
                    else if (col < C_SMALL + 40) { float* sp = small + (size_t)row * 64 + (col - C_SMALL); *(f32x4*)sp = v0; *(f32x4*)(sp + 4) = v1; } } }
    } };
struct EpiOut8 { static constexpr bool PERM = false; const float* x; const float* mod; float* x1;
    __device__ __forceinline__ void operator()(const f32x4 (&acc)[2][2][4][2], const Unit& u, int wr, int wc, int fr, int fq) const {
        const float* g = mod + (u.m0 / T) * 12288 + 2 * 2048;
#pragma unroll
        for (int ai = 0; ai < 2; ++ai)
#pragma unroll
            for (int m = 0; m < 4; ++m) { const int row = u.m0 + ai * HALF + wr * 64 + m * 16 + fr;
#pragma unroll
                for (int bj = 0; bj < 2; ++bj)
#pragma unroll
                    for (int n = 0; n < 2; ++n) { const int col = u.pn * BM + bj * HALF + wc * 32 + 16 * n + 4 * fq; const size_t o = (size_t)row * D + col;
                        const f32x4 xv = *(const f32x4*)(x + o), gv = *(const f32x4*)(g + col); *(f32x4*)(x1 + o) = xv + gv * acc[ai][bj][m][n]; } }
    } };
struct EpiAct8 { static constexpr bool PERM = true; bf16_t* act;
    __device__ __forceinline__ void operator()(const f32x4 (&acc)[2][2][4][2], const Unit& u, int wr, int wc, int fr, int fq) const {
#pragma unroll
        for (int ai = 0; ai < 2; ++ai)
#pragma unroll
            for (int m = 0; m < 4; ++m) { const int row = u.m0 + ai * HALF + wr * 64 + m * 16 + fr;
                if (row < u.rend) { float r[8];
#pragma unroll
                    for (int n = 0; n < 2; ++n)
#pragma unroll
                        for (int j = 0; j < 4; ++j) r[4 * n + j] = silu_f(acc[ai][0][m][n][j]) * acc[ai][1][m][n][j];
                    u32x4 w; w.x = cvt_pk_bf16(r[0], r[1]); w.y = cvt_pk_bf16(r[2], r[3]); w.z = cvt_pk_bf16(r[4], r[5]); w.w = cvt_pk_bf16(r[6], r[7]);
                    *(u32x4*)(act + (size_t)row * EFF + u.pn * HALF + wc * 32 + 8 * fq) = w; } }
    } };
struct EpiY8 { static constexpr bool PERM = true; bf16_t* y; const float* roww;
    __device__ __forceinline__ void operator()(const f32x4 (&acc)[2][2][4][2], const Unit& u, int wr, int wc, int fr, int fq) const {
#pragma unroll
        for (int ai = 0; ai < 2; ++ai)
#pragma unroll
            for (int m = 0; m < 4; ++m) { const int row = u.m0 + ai * HALF + wr * 64 + m * 16 + fr;
                if (row < u.rend) {
#pragma unroll
                    for (int bj = 0; bj < 2; ++bj) { const f32x4 v0 = acc[ai][bj][m][0], v1 = acc[ai][bj][m][1];
                        u32x4 w; w.x = cvt_pk_bf16(v0[0], v0[1]); w.y = cvt_pk_bf16(v0[2], v0[3]); w.z = cvt_pk_bf16(v1[0], v1[1]); w.w = cvt_pk_bf16(v1[2], v1[3]);
                        *(u32x4*)(y + (size_t)row * D + u.pn * BM + bj * HALF + wc * 32 + 8 * fq) = w; } } }
    } };

template <class Epi, class Sched, class AOff, class BBase>
__device__ __forceinline__ void gemm_phase(G8_LAS unsigned char* lds, const int K, const Sched& S, const Epi& E, const AOff& AO, const char* Abase, const BBase& BB) {
    const int tid = opaque((int)threadIdx.x), wid = __builtin_amdgcn_readfirstlane(tid >> 6), lane = tid & 63, wr = wid >> 2, wc = wid & 3, fr = lane & 15, fq = lane >> 4;
    const int nt = K / BK;
    int RA[2], CA2[2]; unsigned voffB[2];
#pragma unroll
    for (int i = 0; i < 2; ++i) { int R, C; stage_rc(tid * 16 + i * 8192, R, C); const int Rb = Epi::PERM ? ((R & ~31) + perm32r(R & 31)) : R;
        RA[i] = R; CA2[i] = C * 2; voffB[i] = (unsigned)(Rb * K + C) * 2u; }
    const size_t kstep = (size_t)(BK * 2);
    const size_t hstep = (size_t)HALF * K * 2;
    const unsigned ldsw = (unsigned)wid * 1024u;
    const int aoff = lds_byte(wr * 64 + fr, fq * 8), boff = lds_byte(wc * 32 + fr, fq * 8);
#define G8_SA(b, h) (((b) * 2 + (h)) * HTB)
#define G8_SB(b, h) ((4 + (b) * 2 + (h)) * HTB)
#define G8_STAGE(bufoff, gbase, voff) do { _Pragma("unroll") for (int _i = 0; _i < 2; ++_i) \
        __builtin_amdgcn_global_load_lds((const unsigned*)((const char*)(gbase) + (voff)[_i]), (G8_LAS unsigned*)(lds + (bufoff) + ldsw + _i * 8192), 16, 0, 0); } while (0)
#define G8_LDA(dst, b, h) do { _Pragma("unroll") for (int m = 0; m < 4; ++m) _Pragma("unroll") for (int k = 0; k < 2; ++k) dst[m][k] = *(const G8_LAS bf16x8*)(lds + G8_SA(b, h) + aoff + m * 2048 + k * 1024); } while (0)
#define G8_LDB(dst, b, h) do { _Pragma("unroll") for (int n = 0; n < 2; ++n) _Pragma("unroll") for (int k = 0; k < 2; ++k) dst[n][k] = *(const G8_LAS bf16x8*)(lds + G8_SB(b, h) + boff + n * 2048 + k * 1024); } while (0)
#define G8_MMA(ai, bj, At, Bt) do { __builtin_amdgcn_s_setprio(1); _Pragma("unroll") for (int m = 0; m < 4; ++m) _Pragma("unroll") for (int n = 0; n < 2; ++n) _Pragma("unroll") for (int k = 0; k < 2; ++k) \
        acc[ai][bj][m][n] = __builtin_amdgcn_mfma_f32_16x16x32_bf16(Bt[n][k], At[m][k], acc[ai][bj][m][n], 0, 0, 0); __builtin_amdgcn_s_setprio(0); } while (0)
#define G8_WAIT_V(n) asm volatile("s_waitcnt vmcnt(" #n ")" ::: "memory")
#define G8_WAIT_L(n) asm volatile("s_waitcnt lgkmcnt(" #n ")" ::: "memory")
#define G8_BAR __builtin_amdgcn_s_barrier()
#define G8_SCHED __builtin_amdgcn_sched_barrier(0)
#define G8_AOFF(dst, un) do { _Pragma("unroll") for (int _h = 0; _h < 2; ++_h) _Pragma("unroll") for (int _i = 0; _i < 2; ++_i) dst[_h][_i] = AO.off(un, _h * HALF + RA[_i]) + (unsigned)CA2[_i]; } while (0)
    Unit cur, nxt; int ui = 0;
    if (!S.next(0, cur)) return;
    f32x4 acc[2][2][4][2];
#pragma unroll
    for (int a = 0; a < 2; ++a)
#pragma unroll
        for (int b = 0; b < 2; ++b)
#pragma unroll
            for (int m = 0; m < 4; ++m)
#pragma unroll
                for (int n = 0; n < 2; ++n) acc[a][b][m][n] = (f32x4){0.f, 0.f, 0.f, 0.f};
    bf16x8 At[4][2], B0[2][2], B1[2][2];
    unsigned vA[2][2];
    G8_AOFF(vA, cur);
    asm volatile("s_waitcnt vmcnt(0)" ::: "memory");
    const char* cB = BB.base(cur);
    G8_STAGE(G8_SB(0, 0), cB, voffB); G8_STAGE(G8_SA(0, 0), Abase, vA[0]); G8_STAGE(G8_SB(0, 1), cB + hstep, voffB); G8_STAGE(G8_SA(0, 1), Abase, vA[1]);
    if (wr == 1) G8_BAR;
    G8_WAIT_V(4); G8_BAR;
    G8_STAGE(G8_SB(1, 0), cB + kstep, voffB); G8_STAGE(G8_SA(1, 0), Abase + kstep, vA[0]); G8_STAGE(G8_SB(1, 1), cB + hstep + kstep, voffB);
    G8_WAIT_V(6); G8_BAR;
    for (;;) {
        const bool has_next = S.next(ui + 1, nxt);
        const char* nB = has_next ? BB.base(nxt) : cB;
        for (int t = 0; t < nt; t += 2) {
            const bool last = (t == nt - 2);
            const char* a1 = Abase + (size_t)(t + 1) * kstep;
            const char* a2 = last ? Abase : Abase + (size_t)(t + 2) * kstep; const char* b2 = last ? nB : cB + (size_t)(t + 2) * kstep;
            const char* a3 = a2 + kstep; const char* b3 = b2 + kstep;
            G8_LDB(B0, 0, 0); G8_SCHED; G8_LDA(At, 0, 0); G8_STAGE(G8_SA(1, 1), a1, vA[1]);
            if (last && has_next) { G8_AOFF(vA, nxt); if (AOff::LOADS) asm volatile("s_waitcnt vmcnt(0)" ::: "memory"); }
            G8_WAIT_L(8); G8_BAR; G8_WAIT_L(0); G8_MMA(0, 0, At, B0); G8_BAR; G8_SCHED;
            G8_LDB(B1, 0, 1); G8_STAGE(G8_SB(0, 0), b2, voffB);
            G8_BAR; G8_WAIT_L(0); G8_MMA(0, 1, At, B1); G8_BAR;
            G8_LDA(At, 0, 1); G8_STAGE(G8_SA(0, 0), a2, vA[0]);
            G8_BAR; G8_WAIT_L(0); G8_MMA(1, 0, At, B0); G8_BAR; G8_SCHED;
            G8_STAGE(G8_SB(0, 1), b2 + hstep, voffB);
            G8_WAIT_V(6); G8_BAR; G8_MMA(1, 1, At, B1); G8_BAR;
            G8_LDB(B0, 1, 0); G8_SCHED; G8_LDA(At, 1, 0); G8_STAGE(G8_SA(0, 1), a2, vA[1]);
            G8_WAIT_L(8); G8_BAR; G8_WAIT_L(0); G8_MMA(0, 0, At, B0); G8_BAR; G8_SCHED;
            G8_LDB(B1, 1, 1); G8_STAGE(G8_SB(1, 0), b3, voffB);
            G8_BAR; G8_WAIT_L(0); G8_MMA(0, 1, At, B1); G8_BAR;
            G8_LDA(At, 1, 1); G8_STAGE(G8_SA(1, 0), a3, vA[0]);
            G8_BAR; G8_WAIT_L(0); G8_MMA(1, 0, At, B0); G8_BAR; G8_SCHED;
            G8_STAGE(G8_SB(1, 1), b3 + hstep, voffB);
            G8_WAIT_V(6); G8_BAR; G8_MMA(1, 1, At, B1); G8_BAR;
        }
        E(acc, cur, wr, wc, fr, fq);
        if (!has_next) break;
#pragma unroll
        for (int a = 0; a < 2; ++a)
#pragma unroll
            for (int b = 0; b < 2; ++b)
#pragma unroll
                for (int m = 0; m < 4; ++m)
#pragma unroll
                    for (int n = 0; n < 2; ++n) acc[a][b][m][n] = (f32x4){0.f, 0.f, 0.f, 0.f};
        cur = nxt; cB = nB; ++ui;
    }
    G8_WAIT_V(0);
    if (wr == 0) G8_BAR;
    G8_BAR;
#undef G8_SA
#undef G8_SB
#undef G8_STAGE
#undef G8_LDA
#undef G8_LDB
#undef G8_MMA
#undef G8_WAIT_V
#undef G8_WAIT_L
#undef G8_BAR
#undef G8_SCHED
#undef G8_AOFF
}
}

__device__ __forceinline__ void phase_moe_gemm8(const Params& p, int which, int bid, int nb, unsigned char* smem) {
    int* offs = (int*)(smem + g8::STAGE_BYTES); int* tst = offs + 72;
    moe_offsets(p, offs);
    const int ntn = which ? 8 : 4;
    if (opaque((int)threadIdx.x) == 0) { int s = 0; for (int e = 0; e < 65; ++e) { tst[e] = s; s += ((offs[e + 1] - offs[e] + 255) >> 8) * ntn; } tst[65] = s; }
    __syncthreads();
    g8::MoeSched S{(const G8_LAS int*)tst, (const G8_LAS int*)offs, nb, bid, 0, ntn};
    if (which == 0) {
        g8::EpiAct8 E{(bf16_t*)(p.ws + OFF_ACT)}; g8::AGather AO{(const int*)(p.ws + OFF_STOK), (unsigned)(D * 2)};
        g8::BGroup BB{(const char*)(p.ws + OFF_GUT), (size_t)256 * 2048 * 2, (size_t)1024 * 2048 * 2};
        g8::gemm_phase((G8_LAS unsigned char*)smem, 2048, S, E, AO, (const char*)(p.ws + OFF_H), BB);
    } else {
        g8::EpiY8 E{(bf16_t*)(p.ws + OFF_Y), (const float*)(p.ws + OFF_ROWW)}; g8::ADirect AO{(unsigned)(EFF * 2)};
        g8::BGroup BB{(const char*)(p.ws + OFF_DNT), (size_t)256 * 512 * 2, (size_t)2048 * 512 * 2};
        g8::gemm_phase((G8_LAS unsigned char*)smem, 512, S, E, AO, (const char*)(p.ws + OFF_ACT), BB);
    }
    __syncthreads();
}

constexpr int LDS_BYTES = LDS_BYTES_C;

__global__ void __launch_bounds__(512, 2) k_mega(Params p) {
    const int bid = blockIdx.x, nb = gridDim.x;
    unsigned char* smem = dyn_smem;
    unsigned* ctrl = (unsigned*)(p.ws + OFF_CTRL);
    volatile LAS unsigned* xbw = (volatile LAS unsigned*)(dyn_smem + LDS_BYTES - 16);
    if (threadIdx.x == 0) { xbw[0] = 0u; xbw[1] = 0u; xbw[2] = 0u; xbw[3] = 0u; LAS int* qs = (LAS int*)(dyn_smem + LDS_BYTES - 128); qs[3] = 0; qs[4] = 0; }
    __syncthreads();
    XcdBarrier bar = xcd_barrier_post(ctrl, xbw);
    const float* mod = (const float*)(p.ws + OFF_MOD);
#ifndef REPEAT_PHASE
#define REPEAT_PHASE -1
#endif
#define REP(k) for (int rep_ = 0; rep_ < ((REPEAT_PHASE == (k)) ? 2 : 1); ++rep_, ((REPEAT_PHASE == (k)) && rep_ == 1) ? xcd_barrier(bar) : (void)0)
    REP(0) phase_prologue(p, bid, nb, smem);
    xcd_barrier(bar);
    REP(1) phase_modulate(p.x, p.norm_attn_w, mod, 0, 1, (bf16_t*)(p.ws + OFF_H), bid, nb);
    xcd_barrier(bar);
    if (nb == 256 && bid >= 216) phase_expert_convert(p, &ctrl[CW_Q0 + 128], smem, 48);
    else REP(2) { g8::DenseSched S; S.init(NTOK, PROJ_LD, nb == 256 ? 216 : nb, bid); g8::EpiProj8 E{(bf16_t*)(p.ws + OFF_PROJ), (float*)(p.ws + OFF_SMALL)}; g8::ADirect AO{(unsigned)(D * 2)};
      g8::BDense BB{(const char*)(p.ws + OFF_WINT), (size_t)256 * D * 2};
      g8::gemm_phase((G8_LAS unsigned char*)smem, D, S, E, AO, (const char*)(p.ws + OFF_H), BB); }
    xcd_barrier_work(bar, p, &ctrl[CW_Q0 + 128], smem);
    REP(3) { phase_cmp1(p, bid, nb, smem); phase_gdn_prep(p, bid, nb, smem); }
    xcd_barrier_work(bar, p, &ctrl[CW_Q0 + 128], smem);
    REP(5) phase_cmp2(p, bid, nb, smem);
    xcd_barrier_work(bar, p, &ctrl[CW_Q0 + 128], smem);
    REP(6) {
    for (int j = bid; j < 16; j += nb) phase_gdn_scan(p, j, smem);
    constexpr int CONV_FIRST = 80;
    const bool conv_first = (nb >= 192) && (bid >= nb - CONV_FIRST);
    for (int stg = 0; stg < 2; ++stg) {
        if ((stg == 0) == conv_first) phase_expert_convert(p, &ctrl[CW_Q0 + 128], smem);
        else {
            LAS int* qslot = (LAS int*)(dyn_smem + LDS_BYTES - 32);
            for (;;) {
                __syncthreads();
                if (threadIdx.x == 0) *qslot = (int)__hip_atomic_fetch_add(&ctrl[CW_Q0 + 64 * rep_], 1u, __ATOMIC_RELAXED, __HIP_MEMORY_SCOPE_AGENT);
                __syncthreads();
                const int i = *qslot;
                if (i >= 256) break;
                nsa_job(p, ((i & 3) << 6) | (63 - (i >> 2)), smem);
            }
        }
    }
    }
    xcd_barrier_work(bar, p, &ctrl[CW_Q0 + 128], smem);
    REP(13) phase_gdn_out(p, bid, nb, smem);
    xcd_barrier(bar);
    REP(7) { g8::DenseSched S; S.init(NTOK, D, nb, bid); g8::EpiOut8 E{p.x, mod, (float*)(p.ws + OFF_X1)}; g8::ADirect AO{(unsigned)(D * 2)};
      g8::BDense BB{(const char*)(p.ws + OFF_WOUTT), (size_t)256 * D * 2};
      g8::gemm_phase((G8_LAS unsigned char*)smem, D, S, E, AO, (const char*)(p.ws + OFF_YCAT), BB); }
    xcd_barrier(bar);
    REP(8) phase_router(p, bid, nb, smem, (REPEAT_PHASE == 8 && rep_ == 0) ? 128 : 0);
    xcd_barrier(bar);
    REP(9) phase_scatter(p, bid, nb, smem);
    xcd_barrier(bar);
    REP(10) phase_moe_gemm8(p, 0, bid, nb, smem);
    xcd_barrier(bar);
    REP(11) phase_moe_gemm8(p, 1, bid, nb, smem);
    xcd_barrier(bar);
    REP(12) phase_final(p, bid, nb, smem);
}

extern "C" void kernel_launch(void* const* d_in, const int* in_sizes, int n_in, void* d_out, int out_size, void* d_ws, size_t ws_size, hipStream_t stream) {
    (void)in_sizes; (void)n_in; (void)out_size; (void)ws_size;
    Params p{};
    const float** f = (const float**)&p;
    for (int i = 0; i < 27; ++i) f[i] = (const float*)d_in[i];
    p.out = (float*)d_out; p.ws = (unsigned char*)d_ws;
    static int grid = 0;
    if (!grid) {
        int dev = 0, cus = 0, per_cu = 0;
        (void)hipGetDevice(&dev);
        (void)hipDeviceGetAttribute(&cus, hipDeviceAttributeMultiprocessorCount, dev);
        (void)hipFuncSetAttribute((const void*)k_mega, hipFuncAttributeMaxDynamicSharedMemorySize, LDS_BYTES);
        (void)hipOccupancyMaxActiveBlocksPerMultiprocessor(&per_cu, (const void*)k_mega, NTHR, LDS_BYTES);
        if (cus <= 0) cus = 256;
        grid = cus;
        (void)per_cu;
    }
    (void)hipMemsetAsync((char*)d_ws + OFF_CTRL, 0, CTRL_BYTES, stream);
    hipLaunchKernelGGL(k_mega, dim3(grid), dim3(NTHR), LDS_BYTES, stream, p);
}
```

```cpp
#include <hip/hip_runtime.h>
#include <stdint.h>

typedef unsigned short bf16_t;
typedef short bf16x8 __attribute__((ext_vector_type(8)));
typedef float f32x4 __attribute__((ext_vector_type(4)));
typedef float f32x16 __attribute__((ext_vector_type(16)));

extern __shared__ __attribute__((aligned(16))) unsigned char dyn_smem[];
constexpr int LDS_BYTES_C = 152 * 1024;
__device__ __forceinline__ unsigned char* dyn_smem_base() { return dyn_smem; }
constexpr int NB = 2, T = 4096, NTOK = NB * T, D = 2048;
constexpr int PROJ_LD = 6912;
constexpr int C_QKV = 0, C_GATEG = 3072, C_QN = 4096, C_KCMP = 5120, C_VCMP = 5376, C_KSLC = 5632, C_VSLC = 5888, C_KWIN = 6144, C_VWIN = 6400, C_SMALL = 6656;
constexpr int NEXP = 64, EFF = 512, TOPK = 8;
constexpr int NROWS_MOE = NTOK * TOPK + NTOK;
constexpr int NTHR = 512;

constexpr size_t al256(size_t x) { return (x + 255) & ~(size_t)255; }
constexpr size_t OFF_CTRL = 0;
constexpr size_t CTRL_BYTES = 65536;
constexpr size_t OFF_MOD = OFF_CTRL + CTRL_BYTES;
constexpr size_t OFF_BIAS1 = al256(OFF_MOD + 2 * 12288 * 4);
constexpr size_t OFF_EGL = al256(OFF_BIAS1 + 2 * 256 * 4);
constexpr size_t OFF_X1 = al256(OFF_EGL + 1024 * 4);
constexpr size_t OFF_TKIDX = al256(OFF_X1 + (size_t)NTOK * D * 4);
constexpr size_t OFF_TKW = al256(OFF_TKIDX + (size_t)NTOK * 8 * 4);
constexpr size_t OFF_SLOT = al256(OFF_TKW + (size_t)NTOK * 8 * 4);
constexpr size_t OFF_POS = al256(OFF_SLOT + (size_t)NTOK * 8 * 4);
constexpr size_t OFF_STOK = al256(OFF_POS + (size_t)NTOK * 8 * 4);
constexpr size_t OFF_ROWW = al256(OFF_STOK + (size_t)(NROWS_MOE + 256) * 4);
constexpr size_t OFF_ACT = al256(OFF_ROWW + (size_t)(NROWS_MOE + 256) * 4);
constexpr size_t OFF_DNT = al256(OFF_ACT + (size_t)(NROWS_MOE + 256) * EFF * 2);
constexpr size_t OFF_REGB = al256(OFF_DNT + (size_t)65 * 2048 * 512 * 2);
constexpr size_t OFF_Y = OFF_REGB;
constexpr size_t OFF_WINT = OFF_REGB;
constexpr size_t OFF_WOUTT = al256(OFF_WINT + (size_t)PROJ_LD * D * 2);
constexpr size_t OFF_W1T = al256(OFF_WOUTT + (size_t)D * D * 2);
constexpr size_t OFF_W2T = al256(OFF_W1T + (size_t)2 * 256 * 4096 * 2);
constexpr size_t OFF_GUT = al256(OFF_W2T + (size_t)2 * 128 * 256 * 2);
constexpr size_t OFF_H = al256(OFF_GUT + (size_t)65 * 1024 * 2048 * 2);
constexpr size_t OFF_PROJ = al256(OFF_H + (size_t)NTOK * D * 2);
constexpr size_t OFF_SMALL = al256(OFF_PROJ + (size_t)NTOK * PROJ_LD * 2);
constexpr size_t OFF_GNEGW = al256(OFF_SMALL + (size_t)NTOK * 64 * 4);
constexpr size_t OFF_GQD = al256(OFF_GNEGW + (size_t)1024 * 64 * 128 * 2);
constexpr size_t OFF_GKDT = al256(OFF_GQD + (size_t)1024 * 64 * 128 * 2);
constexpr size_t OFF_GQK = al256(OFF_GKDT + (size_t)1024 * 128 * 64 * 2);
constexpr size_t OFF_GUT2 = al256(OFF_GQK + (size_t)1024 * 64 * 64 * 2);
constexpr size_t OFF_FLAT = al256(OFF_GUT2 + (size_t)1024 * 128 * 64 * 4);
constexpr size_t OFF_HID = al256(OFF_FLAT + (size_t)2 * 1024 * 4096 * 2);
constexpr size_t OFF_KVC = al256(OFF_HID + (size_t)2 * 1024 * 256 * 2);
constexpr size_t OFF_YCAT = al256(OFF_KVC + (size_t)2 * 1024 * 128 * 2);
constexpr size_t OFF_GSB = al256(OFF_YCAT + (size_t)NTOK * D * 2);
constexpr size_t OFF_GVB = al256(OFF_GSB + (size_t)1024 * 8 * 4 * 64 * 16);
constexpr size_t OFF_RWP = al256(OFF_GVB + (size_t)1024 * 8 * 2 * 64 * 16);
constexpr size_t WS_END = al256(OFF_RWP + (size_t)2048 * 64 * 4);
static_assert(OFF_Y + (size_t)NROWS_MOE * 2048 * 2 <= WS_END, "y must fit region B");
static_assert(WS_END <= (size_t)1073741824, "workspace over 1 GiB");

constexpr int CW_CNT = 4096;
constexpr int CW_Q0 = 4352;

struct Params {
    const float *x, *c, *w_ada, *b_ada, *norm_attn_w, *norm_ffn_w, *norm_final_w, *w_in, *conv_w, *a_log, *dt_bias, *gdn_norm_w;
    const float *pe_k, *w1_k, *w2_k, *pe_v, *w1_v, *w2_v, *w_out, *router_w, *router_bias, *e_gate, *e_up, *e_down, *s_gate, *s_up, *s_down;
    float* out;
    unsigned char* ws;
};

typedef __bf16 bf16x2_t __attribute__((ext_vector_type(2)));
typedef float f32x2_t __attribute__((ext_vector_type(2)));
__device__ __forceinline__ unsigned pack2(float lo, float hi) { const f32x2_t v = {lo, hi}; return __builtin_bit_cast(unsigned, __builtin_convertvector(v, bf16x2_t)); }
__device__ __forceinline__ bf16_t f2bf(float f) { return __builtin_bit_cast(unsigned short, (__bf16)f); }
__device__ __forceinline__ float bf2f(bf16_t b) { return __uint_as_float(((unsigned)b) << 16); }
__device__ __forceinline__ float silu_f(float x) { return x / (1.f + __expf(-x)); }
__device__ __forceinline__ float sigmoid_f(float x) { return 1.f / (1.f + __expf(-x)); }
__device__ __forceinline__ float softplus_f(float x) { return fmaxf(x, 0.f) + log1pf(__expf(-fabsf(x))); }
__device__ __forceinline__ int perm32(int dl) { return 8 * ((dl >> 2) & 3) + 4 * (dl >> 4) + (dl & 3); }
__device__ __forceinline__ int perm16(int kl) { return 8 * ((kl >> 2) & 1) + 4 * (kl >> 3) + (kl & 3); }
__device__ __forceinline__ int opaque(int x) { asm volatile("" : "+v"(x)); return x; }
#define LDS_BARRIER() do { __builtin_amdgcn_fence(__ATOMIC_RELEASE, "wavefront"); __builtin_amdgcn_s_waitcnt(0xc07f)  ; __builtin_amdgcn_s_barrier(); __builtin_amdgcn_fence(__ATOMIC_ACQUIRE, "wavefront"); } while (0)
#define MFMA32(a, b, c) __builtin_amdgcn_mfma_f32_32x32x16_bf16((a), (b), (c), 0, 0, 0)
__device__ __forceinline__ float wave_sum(float v) {
#pragma unroll
    for (int o = 32; o > 0; o >>= 1) v += __shfl_xor(v, o);
    return v;
}


#define XB_TMO      128
#define XB_XCNT(j)  (256  + 64 * (j))
#define XB_XSUB(j)  (1280 + 64 * (j))
#define XB_XGEN(j)  (2304 + 64 * (j))
#define XB_TOP      3328
#define XB_TOPGEN   3392
#define XCD_BAR_WORDS 3456
#define XB_SPIN_CAP (1u << 18)
#define LAS __attribute__((address_space(3)))

__device__ __forceinline__ unsigned xb_ld(unsigned* p)              { return __hip_atomic_load(p, __ATOMIC_RELAXED, __HIP_MEMORY_SCOPE_AGENT); }
__device__ __forceinline__ unsigned xb_add(unsigned* p, unsigned v) { return __hip_atomic_fetch_add(p, v, __ATOMIC_RELAXED, __HIP_MEMORY_SCOPE_AGENT); }
__device__ __forceinline__ unsigned xb_xcc_id() { return (unsigned)__builtin_amdgcn_s_getreg((3 << 11) | 20) & 0xFu; }
#define XB_SPIN(cond, bar) do { unsigned _sp = 0; while (cond) { __builtin_amdgcn_s_sleep(1); \
    if ((++_sp & 255u) == 0u) { if (xb_ld(&(bar)[XB_TMO])) break; if (_sp > XB_SPIN_CAP) { atomicAdd(&(bar)[XB_TMO], 1u); break; } } } } while (0)

struct XcdBarrier {
    unsigned* bar; unsigned x;
    volatile LAS unsigned* st;
};

__device__ __forceinline__ XcdBarrier xcd_barrier_post(unsigned* bar, volatile LAS unsigned* st) {
    XcdBarrier b; b.bar = bar; b.x = xb_xcc_id(); b.st = st;
    if (threadIdx.x == 0) (void)xb_add(&bar[XB_XCNT(b.x)], 1u);
    return b;
}
__device__ __forceinline__ void xcd_barrier_complete(unsigned* bar, unsigned x, unsigned& nloc, unsigned& nx) {
    const unsigned G = gridDim.x * gridDim.y * gridDim.z;
    unsigned sum, cnt, mine, sp = 0u;
    for (;;) {
        sum = 0u; cnt = 0u; mine = 0u;
#pragma unroll
        for (unsigned j = 0; j < 16; ++j) { const unsigned c = xb_ld(&bar[XB_XCNT(j)]); sum += c; cnt += (c > 0u) ? 1u : 0u; mine = (j == x) ? c : mine; }
        if (sum == G) break;
        __builtin_amdgcn_s_sleep(1);
        if ((++sp & 255u) == 0u) { if (xb_ld(&bar[XB_TMO])) break; if (sp > XB_SPIN_CAP) { atomicAdd(&bar[XB_TMO], 1u); break; } }
    }
    nloc = mine > 0u ? mine : 1u; nx = cnt > 0u ? cnt : 1u;
}

__device__ __forceinline__ void xcd_barrier(const XcdBarrier& b) {
    asm volatile("s_waitcnt vmcnt(0)" ::: "memory");
    __syncthreads();
    if (threadIdx.x == 0) {
        unsigned* bar = b.bar;
        __builtin_amdgcn_s_waitcnt(0);
        unsigned nloc = b.st[0], nx = b.st[1];
        if (nloc == 0u) { xcd_barrier_complete(bar, b.x, nloc, nx); b.st[0] = nloc; b.st[1] = nx; }
        const unsigned old = xb_add(&bar[XB_XSUB(b.x)], 1u);
        const unsigned gen = old / nloc;
        if (old + 1u == (gen + 1u) * nloc) {
            __builtin_amdgcn_fence(__ATOMIC_RELEASE, "agent");
            asm volatile("s_waitcnt vmcnt(0)" ::: "memory");
            const unsigned og = xb_add(&bar[XB_TOP], 1u);
            const unsigned tg = og / nx;
            if (og + 1u == (tg + 1u) * nx) xb_add(&bar[XB_TOPGEN], 1u);
            else XB_SPIN(xb_ld(&bar[XB_TOPGEN]) == tg, bar);
            __builtin_amdgcn_fence(__ATOMIC_ACQUIRE, "agent");
            xb_add(&bar[XB_XGEN(b.x)], 1u);
            asm volatile("s_waitcnt vmcnt(0)" ::: "memory");
        } else {
            XB_SPIN(xb_ld(&bar[XB_XGEN(b.x)]) == gen, bar);
            __builtin_amdgcn_fence(__ATOMIC_ACQUIRE, "agent");
            asm volatile("s_waitcnt vmcnt(0)" ::: "memory");
        }
    }
    __syncthreads();
}

struct ColFn { const float* p0; const float* p1; int mode; };
__device__ __forceinline__ const float* colptr(const ColFn& f, int n) {
    if (f.mode == 0) return f.p0 + n;
    if (f.mode == 1) {
        int src;
        if (n < 3072) src = n; else if (n < 6656) src = n + 16; else if (n < 6672) src = 3072 + (n - 6656); else if (n < 6696) src = n; else return nullptr;
        return f.p0 + src;
    }
    const int jb = n >> 8, wi = n & 255;
    const long long dlt = (wi < 128) ? 0ll : (long long)(f.p1 - f.p0);
    return f.p0 + dlt + jb * 128 + (wi & 127);
}
struct TileRegs { f32x4 v[8]; };
__device__ __forceinline__ void tp_load(const ColFn& f, int ld_src, int n0, int k0, int tid, TileRegs& r) {
    const int c4 = tid & 31, rp = tid >> 5;
    const float* cp = colptr(f, n0 + 4 * c4);
#pragma unroll
    for (int p = 0; p < 4; ++p)
#pragma unroll
        for (int q = 0; q < 2; ++q) { const int k = k0 + 32 * p + 2 * rp + q; r.v[2 * p + q] = cp ? *(const f32x4*)(cp + (size_t)k * ld_src) : (f32x4){0.f, 0.f, 0.f, 0.f}; }
}
__device__ __forceinline__ void tp_store(const TileRegs& r, bf16_t* dst, int ld_dst, int n0, int k0, int tid, unsigned* tile) {
    const int c4 = tid & 31, rp = tid >> 5;
#pragma unroll
    for (int p = 0; p < 4; ++p)
#pragma unroll
        for (int i = 0; i < 4; ++i) tile[(4 * c4 + i) * 65 + 16 * p + rp] = pack2(r.v[2 * p][i], r.v[2 * p + 1][i]);
    LDS_BARRIER();
    { const int n = tid >> 2, q = tid & 3; const unsigned* tp = tile + n * 65 + q * 16;
      unsigned* dp = (unsigned*)(dst + (size_t)(n0 + n) * ld_dst + k0 + q * 32);
#pragma unroll
      for (int j = 0; j < 4; ++j) { uint4 o; o.x = tp[4 * j]; o.y = tp[4 * j + 1]; o.z = tp[4 * j + 2]; o.w = tp[4 * j + 3]; *(uint4*)(dp + 4 * j) = o; } }
    LDS_BARRIER();
}

constexpr int J_WIN = 54 * 16, J_WOUT = 16 * 16, J_W1 = 2 * 2 * 32, J_W2 = 2 * 2, J_GU = 65 * 8 * 16, J_DN = 65 * 16 * 4;
constexpr int J_TP = J_WIN + J_WOUT + J_W1 + J_W2 + J_GU + J_DN;
constexpr int J_EARLY = J_WIN + J_WOUT + J_W1 + J_W2;
struct TpJob { ColFn f; int ld_src; bf16_t* dst; int ld_dst, n0, k0; };
__device__ __forceinline__ void tp_decode(const Params& p, int j, TpJob& t) {
    if (j < J_WIN) { t.f = ColFn{p.w_in, nullptr, 1}; t.ld_src = 6696; t.dst = (bf16_t*)(p.ws + OFF_WINT); t.ld_dst = 2048; t.n0 = (j >> 4) * 128; t.k0 = (j & 15) * 128; return; }
    j -= J_WIN;
    if (j < J_WOUT) { t.f = ColFn{p.w_out, nullptr, 0}; t.ld_src = 2048; t.dst = (bf16_t*)(p.ws + OFF_WOUTT); t.ld_dst = 2048; t.n0 = (j >> 4) * 128; t.k0 = (j & 15) * 128; return; }
    j -= J_WOUT;
    if (j < J_W1) { const int which = j >> 6, r = j & 63; const float* w = p.w1_k + (which ? (long long)(p.w1_v - p.w1_k) : 0ll);
        t.f = ColFn{w, nullptr, 0}; t.ld_src = 256; t.dst = (bf16_t*)(p.ws + OFF_W1T) + (size_t)which * 256 * 4096; t.ld_dst = 4096; t.n0 = (r >> 5) * 128; t.k0 = (r & 31) * 128; return; }
    j -= J_W1;
    if (j < J_W2) { const int which = j >> 1, r = j & 1; const float* w = p.w2_k + (which ? (long long)(p.w2_v - p.w2_k) : 0ll);
        t.f = ColFn{w, nullptr, 0}; t.ld_src = 128; t.dst = (bf16_t*)(p.ws + OFF_W2T) + (size_t)which * 128 * 256; t.ld_dst = 256; t.n0 = 0; t.k0 = r * 128; return; }
    j -= J_W2;
    if (j < J_GU) { const int e = j >> 7, r = j & 127;
        const float* g0 = p.e_gate + (e < 64 ? (long long)e * 2048 * 512 : (long long)(p.s_gate - p.e_gate));
        const float* g1 = p.e_up + (e < 64 ? (long long)e * 2048 * 512 : (long long)(p.s_up - p.e_up));
        t.f = ColFn{g0, g1, 2}; t.ld_src = 512; t.dst = (bf16_t*)(p.ws + OFF_GUT) + (size_t)e * 1024 * 2048; t.ld_dst = 2048; t.n0 = (r >> 4) * 128; t.k0 = (r & 15) * 128; return; }
    j -= J_GU;
    { const int e = j >> 6, r = j & 63;
        const float* g0 = p.e_down + (e < 64 ? (long long)e * 512 * 2048 : (long long)(p.s_down - p.e_down));
        t.f = ColFn{g0, nullptr, 0}; t.ld_src = 2048; t.dst = (bf16_t*)(p.ws + OFF_DNT) + (size_t)e * 2048 * 512; t.ld_dst = 512; t.n0 = (r >> 2) * 128; t.k0 = (r & 3) * 128; }
}

constexpr int J_MOD = 192, J_B1 = 8;
__device__ __forceinline__ void phase_prologue(const Params& p, int bid, int nb, unsigned char* smem) {
    float* sf = (float*)smem;
    const int tid = opaque((int)threadIdx.x);
    for (int j = bid; j < J_MOD; j += nb) {
        float* sc = sf;
        float* red = sf + 4096;
        for (int i = tid; i < 4096; i += NTHR) sc[i] = silu_f(p.c[i]);
        __syncthreads();
        const int cg = tid & 15, kl = tid >> 4, j0 = j * 64 + cg * 4;
        float a0[4] = {0, 0, 0, 0}, a1[4] = {0, 0, 0, 0};
        for (int kb = 0; kb < 2048; kb += 256) {
            f32x4 w[8];
#pragma unroll
            for (int u = 0; u < 8; ++u) w[u] = *(const f32x4*)(p.w_ada + (size_t)(kb + 32 * u + kl) * 12288 + j0);
#pragma unroll
            for (int u = 0; u < 8; ++u) { const float c0 = sc[kb + 32 * u + kl], c1 = sc[2048 + kb + 32 * u + kl];
#pragma unroll
                for (int q = 0; q < 4; ++q) { a0[q] += c0 * w[u][q]; a1[q] += c1 * w[u][q]; } }
        }
#pragma unroll
        for (int q = 0; q < 4; ++q) { red[(kl * 16 + cg) * 8 + q] = a0[q]; red[(kl * 16 + cg) * 8 + 4 + q] = a1[q]; }
        __syncthreads();
        if (tid < 128) {
            const int b = tid >> 6, col = tid & 63, cg2 = col >> 2, q = col & 3;
            float s = 0.f;
            for (int k2 = 0; k2 < 32; ++k2) s += red[(k2 * 16 + cg2) * 8 + b * 4 + q];
            ((float*)(p.ws + OFF_MOD))[b * 12288 + j * 64 + col] = s + p.b_ada[j * 64 + col];
        }
        __syncthreads();
    }
    for (int j = (bid + nb - (J_MOD % nb)) % nb; j < J_B1; j += nb) {
        const int which = j >> 2, jb = j & 3;
        const float* pe = p.pe_k + (which ? (long long)(p.pe_v - p.pe_k) : 0ll);
        const float* w1 = p.w1_k + (which ? (long long)(p.w1_v - p.w1_k) : 0ll);
        const int col = tid & 63, kl = tid >> 6;
        float acc = 0.f;
#pragma unroll 8
        for (int kk = kl; kk < 4096; kk += 8) acc += pe[kk] * w1[(size_t)kk * 256 + jb * 64 + col];
        sf[kl * 64 + col] = acc;
        __syncthreads();
        if (tid < 64) { float s = 0.f; for (int k2 = 0; k2 < 8; ++k2) s += sf[k2 * 64 + tid]; ((float*)(p.ws + OFF_BIAS1))[which * 256 + jb * 64 + tid] = s; }
        __syncthreads();
    }
    { float* rwp = (float*)(p.ws + OFF_RWP);
      for (int i = bid * NTHR + tid; i < 2048 * 64; i += nb * NTHR) { const int k = i >> 6, c = i & 63; rwp[i] = p.router_w[(size_t)k * 64 + 16 * (c & 3) + (c >> 2)]; } }
    {
        unsigned* tile = (unsigned*)smem;
        int j = bid;
        TpJob cur; TileRegs rc;
        if (j < J_EARLY) { tp_decode(p, j, cur); tp_load(cur.f, cur.ld_src, cur.n0, cur.k0, tid, rc); }
        while (j < J_EARLY) {
            const int jn = j + nb;
            TpJob nxt; TileRegs rn;
            if (jn < J_EARLY) { tp_decode(p, jn, nxt); tp_load(nxt.f, nxt.ld_src, nxt.n0, nxt.k0, tid, rn); }
            tp_store(rc, cur.dst, cur.ld_dst, cur.n0, cur.k0, tid, tile);
            cur = nxt; rc = rn; j = jn;
        }
    }
}

__device__ __forceinline__ int ec_next_id(unsigned* qhead, LAS int* qs) {
    int nx = qs[3];
    if (nx >= qs[4]) { nx = J_EARLY + 8 * (int)__hip_atomic_fetch_add(qhead, 1u, __ATOMIC_RELAXED, __HIP_MEMORY_SCOPE_AGENT); qs[4] = nx + 8; }
    qs[3] = nx + 1;
    return nx;
}
__device__ __forceinline__ void phase_expert_convert(const Params& p, unsigned* qhead, unsigned char* smem, int budget = 1 << 30) {
    unsigned* tile = (unsigned*)smem; LAS int* qslot = (LAS int*)(dyn_smem_base() + LDS_BYTES_C - 128);
    const int tid = opaque((int)threadIdx.x);
    __syncthreads();
    if (tid == 0) { for (int i = 0; i < 3; ++i) qslot[i] = ec_next_id(qhead, qslot); }
    __syncthreads();
    int j0 = qslot[0], j1 = qslot[1], j2 = qslot[2];
    __syncthreads();
    TpJob t0, t1, t2; TileRegs r0, r1, r2;
    if (j0 < J_TP) { tp_decode(p, j0, t0); tp_load(t0.f, t0.ld_src, t0.n0, t0.k0, tid, r0); }
    if (j1 < J_TP) { tp_decode(p, j1, t1); tp_load(t1.f, t1.ld_src, t1.n0, t1.k0, tid, r1); }
    if (j2 < J_TP) { tp_decode(p, j2, t2); tp_load(t2.f, t2.ld_src, t2.n0, t2.k0, tid, r2); }
#define EC_STEP(jX, tX, rX) do { \
        if (tid == 0) qslot[0] = (--budget > 0) ? ec_next_id(qhead, qslot) : J_TP; \
        tp_store(rX, tX.dst, tX.ld_dst, tX.n0, tX.k0, tid, tile);                  \
        jX = qslot[0]; \
        LDS_BARRIER(); \
        if (jX < J_TP) { tp_decode(p, jX, tX); tp_load(tX.f, tX.ld_src, tX.n0, tX.k0, tid, rX); } } while (0)
    for (;;) {
        if (j0 >= J_TP) break; EC_STEP(j0, t0, r0);
        if (j1 >= J_TP) break; EC_STEP(j1, t1, r1);
        if (j2 >= J_TP) break; EC_STEP(j2, t2, r2);
    }
    if (j0 < J_TP) tp_store(r0, t0.dst, t0.ld_dst, t0.n0, t0.k0, tid, tile);
    if (j1 < J_TP) tp_store(r1, t1.dst, t1.ld_dst, t1.n0, t1.k0, tid, tile);
    if (j2 < J_TP) tp_store(r2, t2.dst, t2.ld_dst, t2.n0, t2.k0, tid, tile);
#undef EC_STEP
}

__device__ __forceinline__ bool expert_convert_one(const Params& p, unsigned* qhead, unsigned char* smem) {
    unsigned* tile = (unsigned*)smem; LAS int* qslot = (LAS int*)(dyn_smem_base() + LDS_BYTES_C - 128);
    const int tid = opaque((int)threadIdx.x);
    if (tid == 0) qslot[0] = ec_next_id(qhead, qslot);
    __syncthreads();
    const int j = qslot[0];
    __syncthreads();
    if (j >= J_TP) return false;
    TpJob cur; TileRegs rc;
    tp_decode(p, j, cur); tp_load(cur.f, cur.ld_src, cur.n0, cur.k0, tid, rc);
    tp_store(rc, cur.dst, cur.ld_dst, cur.n0, cur.k0, tid, tile);
    return true;
}
__device__ __forceinline__ void xcd_barrier_work(const XcdBarrier& b, const Params& p, unsigned* qhead, unsigned char* smem) {
    asm volatile("s_waitcnt vmcnt(0)" ::: "memory");
    __syncthreads();
    LAS unsigned* wf = (LAS unsigned*)(dyn_smem_base() + LDS_BYTES_C - 80);
    if (threadIdx.x == 0) {
        unsigned* bar = b.bar;
        __builtin_amdgcn_s_waitcnt(0);
        unsigned nloc = b.st[0], nx = b.st[1];
        if (nloc == 0u) { xcd_barrier_complete(bar, b.x, nloc, nx); b.st[0] = nloc; b.st[1] = nx; }
        const unsigned old = xb_add(&bar[XB_XSUB(b.x)], 1u);
        const unsigned gen = old / nloc;
        if (old + 1u == (gen + 1u) * nloc) {
            __builtin_amdgcn_fence(__ATOMIC_RELEASE, "agent");
            asm volatile("s_waitcnt vmcnt(0)" ::: "memory");
            const unsigned og = xb_add(&bar[XB_TOP], 1u);
            const unsigned tg = og / nx;
            if (og + 1u == (tg + 1u) * nx) xb_add(&bar[XB_TOPGEN], 1u);
            else XB_SPIN(xb_ld(&bar[XB_TOPGEN]) == tg, bar);
            __builtin_amdgcn_fence(__ATOMIC_ACQUIRE, "agent");
            xb_add(&bar[XB_XGEN(b.x)], 1u);
            asm volatile("s_waitcnt vmcnt(0)" ::: "memory");
            wf[0] = 1u;
        } else { wf[0] = 0u; wf[1] = gen; }
    }
    __syncthreads();
    if (wf[0] == 0u) {
        const unsigned gen = wf[1];
        bool more = true; unsigned spins = 0u;
        for (;;) {
            if (threadIdx.x == 0) { unsigned rel = (xb_ld(&b.bar[XB_XGEN(b.x)]) != gen) ? 1u : 0u;
                if (!rel && (++spins > XB_SPIN_CAP || ((spins & 255u) == 0u && xb_ld(&b.bar[XB_TMO])))) { if (spins > XB_SPIN_CAP) atomicAdd(&b.bar[XB_TMO], 1u); rel = 1u; }
                wf[2] = rel; }
            __syncthreads();
            const unsigned rel = wf[2];
            __syncthreads();
            if (rel) break;
            if (more) more = expert_convert_one(p, qhead, smem); else __builtin_amdgcn_s_sleep(4);
        }
        if (threadIdx.x == 0) {
            __builtin_amdgcn_fence(__ATOMIC_ACQUIRE, "agent");
            asm volatile("s_waitcnt vmcnt(0)" ::: "memory");
        }
    }
    __syncthreads();
}

__device__ __forceinline__ void phase_modulate(const float* xin, const float* nw, const float* mod, int shift_idx, int scale_idx, bf16_t* hout, int bid, int nb) {
    const int tid_ = opaque((int)threadIdx.x); const int lane0 = tid_ & 63, wv = tid_ >> 6;
    for (int row0 = (bid * 8 + wv) * 2; row0 < NTOK; row0 += nb * 16) {
        const int lane = opaque(lane0);
        f32x4 v[2][8]; float ss[2] = {0.f, 0.f};
#pragma unroll
        for (int rr = 0; rr < 2; ++rr) { const float* xr = xin + (size_t)(row0 + rr) * D;
#pragma unroll
            for (int c = 0; c < 8; ++c) v[rr][c] = *(const f32x4*)(xr + (c * 64 + lane) * 4); }
#pragma unroll
        for (int rr = 0; rr < 2; ++rr) {
#pragma unroll
            for (int c = 0; c < 8; ++c) ss[rr] += v[rr][c][0] * v[rr][c][0] + v[rr][c][1] * v[rr][c][1] + v[rr][c][2] * v[rr][c][2] + v[rr][c][3] * v[rr][c][3];
            ss[rr] = wave_sum(ss[rr]); }
        const int b = row0 / T;
        const float* sh = mod + b * 12288 + shift_idx * 2048; const float* sc = mod + b * 12288 + scale_idx * 2048;
        const float rstd0 = rsqrtf(ss[0] * (1.f / D) + 1e-6f), rstd1 = rsqrtf(ss[1] * (1.f / D) + 1e-6f);
#pragma unroll
        for (int c = 0; c < 8; ++c) { const int col = (c * 64 + lane) * 4;
            const f32x4 w = *(const f32x4*)(nw + col), s1 = *(const f32x4*)(sc + col), s0 = *(const f32x4*)(sh + col);
#pragma unroll
            for (int rr = 0; rr < 2; ++rr) { float o[4]; const float rs = rr ? rstd1 : rstd0;
#pragma unroll
                for (int q = 0; q < 4; ++q) o[q] = v[rr][c][q] * rs * w[q] * (1.f + s1[q]) + s0[q];
                uint2 pk; pk.x = pack2(o[0], o[1]); pk.y = pack2(o[2], o[3]);
                *(uint2*)(hout + (size_t)(row0 + rr) * D + col) = pk; } }
    }
}

struct ARowDirect { const bf16_t* A; int lda; __device__ __forceinline__ const bf16_t* ptr(int r, int k) const { return A + (size_t)r * lda + k; } };
struct ARowWin { const bf16_t* proj; int col0; __device__ __forceinline__ const bf16_t* ptr(int r, int k) const { const int b = r >> 9, kvh = (r >> 8) & 1; int c = r & 255; c = c < 255 ? c : 254;
        return proj + (size_t)(b * T + 16 * c + (k >> 7)) * PROJ_LD + col0 + kvh * 128 + (k & 127); } };
struct ARowGather { const bf16_t* A; int lda; const int* idx; int rlast; __device__ __forceinline__ const bf16_t* ptr(int r, int k) const { return A + (size_t)idx[r < rlast ? r : rlast] * lda + k; } };
struct BRowDirect { const bf16_t* Bt; int ldb; __device__ __forceinline__ const bf16_t* row(int n) const { return Bt + (size_t)n * ldb; } };
struct BRowGateUp { const bf16_t* Bt; int ldb;
    __device__ __forceinline__ const bf16_t* row(int n) const { const int tn = n >> 7, nl = n & 127, u = 64 * tn + 32 * (nl >> 6) + (nl & 31), nt = (nl >> 5) & 1;
        return Bt + (size_t)((u >> 7) * 256 + nt * 128 + (u & 127)) * ldb; } };

constexpr int GS = 72;
template <class AF, class BF, class Epi>
__device__ __forceinline__ void gemm_tile128(const AF& af, const BF& bf, int kbeg, int K, int m0, int n0, const Epi& epi, unsigned char* smem) {
    bf16_t* As = (bf16_t*)smem; bf16_t* Bs = As + 128 * GS;
    const int tid = opaque((int)threadIdx.x), lane = tid & 63, wv = tid >> 6, wm = wv & 3, wn = wv >> 2;
    const int r0 = tid >> 3, kc = (tid & 7) * 8 + kbeg;
    const bf16_t* bp0 = bf.row(n0 + r0) + kc; const bf16_t* bp1 = bf.row(n0 + r0 + 64) + kc;
    f32x16 acc0, acc1;
#pragma unroll
    for (int i = 0; i < 16; ++i) { acc0[i] = 0.f; acc1[i] = 0.f; }
    uint4 ra0 = *(const uint4*)af.ptr(m0 + r0, kc), ra1 = *(const uint4*)af.ptr(m0 + r0 + 64, kc), rb0 = *(const uint4*)bp0, rb1 = *(const uint4*)bp1;
    const int nk = K >> 6;
    const int aoff = (wm * 32 + (lane & 31)) * GS + (lane >> 5) * 8, boff = (wn * 64 + (lane & 31)) * GS + (lane >> 5) * 8;
    for (int kt = 0; kt < nk; ++kt) {
        __syncthreads();
        *(uint4*)(As + r0 * GS + (kc - kbeg)) = ra0; *(uint4*)(As + (r0 + 64) * GS + (kc - kbeg)) = ra1;
        *(uint4*)(Bs + r0 * GS + (kc - kbeg)) = rb0; *(uint4*)(Bs + (r0 + 64) * GS + (kc - kbeg)) = rb1;
        __syncthreads();
        if (kt + 1 < nk) { const int ko = (kt + 1) * 64; ra0 = *(const uint4*)af.ptr(m0 + r0, kc + ko); ra1 = *(const uint4*)af.ptr(m0 + r0 + 64, kc + ko); rb0 = *(const uint4*)(bp0 + ko); rb1 = *(const uint4*)(bp1 + ko); }
#pragma unroll
        for (int ks = 0; ks < 4; ++ks) {
            const bf16x8 a = *(const bf16x8*)(As + aoff + ks * 16);
            const bf16x8 b0 = *(const bf16x8*)(Bs + boff + ks * 16);
            const bf16x8 b1 = *(const bf16x8*)(Bs + boff + 32 * GS + ks * 16);
            acc0 = __builtin_amdgcn_mfma_f32_32x32x16_bf16(a, b0, acc0, 0, 0, 0);
            acc1 = __builtin_amdgcn_mfma_f32_32x32x16_bf16(a, b1, acc1, 0, 0, 0);
        }
    }
#pragma unroll
    for (int r = 0; r < 16; ++r) {
        const int row = m0 + wm * 32 + (r & 3) + 8 * (r >> 2) + 4 * (lane >> 5), col = n0 + wn * 64 + (lane & 31);
        epi(row, col, acc0[r], acc1[r]);
    }
    __syncthreads();
}

struct EpiProj { bf16_t* proj; float* small;
    __device__ __forceinline__ void st(int row, int col, float v) const { if (col < C_SMALL) proj[(size_t)row * PROJ_LD + col] = f2bf(v); else if (col < C_SMALL + 40) small[(size_t)row * 64 + (col - C_SMALL)] = v; }
    __device__ __forceinline__ void operator()(int row, int col, float v0, float v1) const { st(row, col, v0); st(row, col + 32, v1); } };
struct EpiHid { bf16_t* hid; const float* bias;
    __device__ __forceinline__ void operator()(int row, int col, float v0, float v1) const { hid[(size_t)row * 256 + col] = f2bf(silu_f(v0 + bias[col])); hid[(size_t)row * 256 + col + 32] = f2bf(silu_f(v1 + bias[col + 32])); } };
struct EpiKc { bf16_t* o;
    __device__ __forceinline__ void operator()(int row, int col, float v0, float v1) const { o[(size_t)row * 128 + col] = f2bf(v0); o[(size_t)row * 128 + col + 32] = f2bf(v1); } };
struct EpiOut { const float* x; const float* mod; float* x1;
    __device__ __forceinline__ void operator()(int row, int col, float v0, float v1) const { const float* g = mod + (row / T) * 12288 + 2 * 2048; const size_t o = (size_t)row * D + col;
        x1[o] = x[o] + g[col] * v0; x1[o + 32] = x[o + 32] + g[col + 32] * v1; } };
struct EpiAct { bf16_t* act; int rend;
    __device__ __forceinline__ void operator()(int row, int col, float v0, float v1) const { if (row < rend) { const int tn = col >> 7, nl = col & 127, u = 64 * tn + 32 * (nl >> 6) + (nl & 31);
        act[(size_t)row * EFF + u] = f2bf(silu_f(v0) * v1); } } };
struct EpiY { bf16_t* y; const float* roww; int rend;
    __device__ __forceinline__ void operator()(int row, int col, float v0, float v1) const { if (row < rend) { const float w = roww[row]; y[(size_t)row * D + col] = f2bf(v0 * w); y[(size_t)row * D + col + 32] = f2bf(v1 * w); } } };

template <class Epi>
__device__ __forceinline__ void phase_gemm_dense(const bf16_t* A, int lda, const bf16_t* Bt, int M, int N, int K, const Epi& epi, int bid, int nb, unsigned char* smem) {
    const int tm = M / 128, tn = N / 128;
    ARowDirect af{A, lda}; BRowDirect bf{Bt, K};
    for (int t = bid; t < tm * tn; t += nb) gemm_tile128(af, bf, 0, K, (t % tm) * 128, (t / tm) * 128, epi, smem);
}

constexpr int RAWS = 392, QS = 136, AS = 68;
__device__ __forceinline__ void phase_gdn_prep(const Params& p, int bid, int nb, unsigned char* smem) {
    bf16_t* raw = (bf16_t*)smem; float* sV = (float*)smem; float* sW = sV + 64 * 129;
    float* cw = (float*)(smem + 66048);
    bf16_t* sQ = (bf16_t*)(smem + 66048 + 6144); bf16_t* sK = sQ + 64 * QS;
    float* sA = (float*)(smem + 66048 + 6144 + 34816);
    float* s_beta = sA + 64 * AS; float* s_g = s_beta + 64; float* s_gc = s_g + 64; float* s_eg = s_gc + 64;
    const bf16_t* proj = (const bf16_t*)(p.ws + OFF_PROJ); const float* small = (const float*)(p.ws + OFF_SMALL);
    bf16_t* gnegw = (bf16_t*)(p.ws + OFF_GNEGW); bf16_t* gqd = (bf16_t*)(p.ws + OFF_GQD); bf16_t* gkdt = (bf16_t*)(p.ws + OFF_GKDT); bf16_t* gqk = (bf16_t*)(p.ws + OFF_GQK);
    bf16_t* gut = (bf16_t*)(p.ws + OFF_GUT2); float* egl = (float*)(p.ws + OFF_EGL);
    const int tid = opaque((int)threadIdx.x), lane = tid & 63, wv = tid >> 6;
    uint4 pre[7];
#define PREP_LOAD(jb) do { const int bh_ = (jb) >> 6, n_ = (jb) & 63, b_ = bh_ >> 3, h_ = bh_ & 7; \
        _Pragma("unroll") for (int i_ = 0; i_ < 7; ++i_) { const int id = tid + 512 * i_, r = id / 48, c = id - r * 48, tt = n_ * 64 - 3 + r; \
            pre[i_] = make_uint4(0u, 0u, 0u, 0u); \
            if (id < 67 * 48 && tt >= 0) pre[i_] = *(const uint4*)(proj + (size_t)(b_ * T + tt) * PROJ_LD + (c >> 4) * 1024 + h_ * 128 + (c & 15) * 8); } } while (0)
    if (bid < 1024) PREP_LOAD(bid);
    for (int job = bid; job < 1024; job += nb) {
        const int bh = job >> 6, n = job & 63, b = bh >> 3, h = bh & 7;
        const int row0 = b * T + n * 64;
#pragma unroll
        for (int i_ = 0; i_ < 7; ++i_) { const int id = tid + 512 * i_, r = id / 48, c = id - r * 48; if (id < 67 * 48) *(uint4*)(raw + r * RAWS + c * 8) = pre[i_]; }
        for (int id = tid; id < 4 * 384; id += NTHR) { const int i = id / 384, cc = id - i * 384; cw[id] = p.conv_w[i * 3072 + (cc >> 7) * 1024 + h * 128 + (cc & 127)]; }
        if (tid < 64) { const int row = row0 + tid; s_beta[tid] = sigmoid_f(small[(size_t)row * 64 + h]);
            s_g[tid] = -__expf(p.a_log[h]) * softplus_f(small[(size_t)row * 64 + 8 + h] + p.dt_bias[h]); }
        __syncthreads();
        if (tid == 0) { float s = 0.f; for (int t = 0; t < 64; ++t) { s += s_g[t]; s_gc[t] = s; } }
        float vkeep[2][8];
#pragma unroll
        for (int part = 0; part < 3; ++part)
#pragma unroll
            for (int it = 0; it < 2; ++it) {
                const int id = tid + 512 * it, ch = id & 15, t = id >> 4, cc = part * 128 + ch * 8;
                float acc[8];
#pragma unroll
                for (int q = 0; q < 8; ++q) acc[q] = 0.f;
#pragma unroll
                for (int i = 0; i < 4; ++i) { const uint4 rv = *(const uint4*)(raw + (t + i) * RAWS + cc); const f32x4 w0 = *(const f32x4*)(cw + i * 384 + cc), w1 = *(const f32x4*)(cw + i * 384 + cc + 4);
                    acc[0] += w0[0] * bf2f((bf16_t)(rv.x & 0xffff)); acc[1] += w0[1] * bf2f((bf16_t)(rv.x >> 16)); acc[2] += w0[2] * bf2f((bf16_t)(rv.y & 0xffff)); acc[3] += w0[3] * bf2f((bf16_t)(rv.y >> 16));
                    acc[4] += w1[0] * bf2f((bf16_t)(rv.z & 0xffff)); acc[5] += w1[1] * bf2f((bf16_t)(rv.z >> 16)); acc[6] += w1[2] * bf2f((bf16_t)(rv.w & 0xffff)); acc[7] += w1[3] * bf2f((bf16_t)(rv.w >> 16)); }
                float ss = 0.f;
#pragma unroll
                for (int q = 0; q < 8; ++q) { acc[q] = silu_f(acc[q]); ss += acc[q] * acc[q]; }
                if (part < 2) {
                    ss += __shfl_xor(ss, 1); ss += __shfl_xor(ss, 2); ss += __shfl_xor(ss, 4); ss += __shfl_xor(ss, 8);
                    const float rn = rsqrtf(ss + 1e-6f) * (part == 0 ? 0.08838834764831845f : 1.f);
                    uint4 o; o.x = pack2(acc[0] * rn, acc[1] * rn); o.y = pack2(acc[2] * rn, acc[3] * rn); o.z = pack2(acc[4] * rn, acc[5] * rn); o.w = pack2(acc[6] * rn, acc[7] * rn);
                    *(uint4*)((part == 0 ? sQ : sK) + t * QS + ch * 8) = o;
                } else {
#pragma unroll
                    for (int q = 0; q < 8; ++q) vkeep[it][q] = acc[q];
                }
            }
        __syncthreads();
        if (tid < 64) s_eg[tid] = __expf(s_gc[tid]);
#pragma unroll
        for (int it = 0; it < 2; ++it) { const int id = tid + 512 * it, ch = id & 15, t = id >> 4; const float bt = s_beta[t];
#pragma unroll
            for (int q = 0; q < 8; ++q) sV[t * 129 + ch * 8 + q] = vkeep[it][q] * bt; }
#pragma unroll
        for (int it = 0; it < 2; ++it) { const int id = tid + 512 * it, ch = id & 15, t = id >> 4; const float f = s_beta[t] * __expf(s_gc[t]);
            const uint4 kv = *(const uint4*)(sK + t * QS + ch * 8); float* wp = sW + t * 129 + ch * 8;
            wp[0] = bf2f((bf16_t)(kv.x & 0xffff)) * f; wp[1] = bf2f((bf16_t)(kv.x >> 16)) * f; wp[2] = bf2f((bf16_t)(kv.y & 0xffff)) * f; wp[3] = bf2f((bf16_t)(kv.y >> 16)) * f;
            wp[4] = bf2f((bf16_t)(kv.z & 0xffff)) * f; wp[5] = bf2f((bf16_t)(kv.z >> 16)) * f; wp[6] = bf2f((bf16_t)(kv.w & 0xffff)) * f; wp[7] = bf2f((bf16_t)(kv.w >> 16)) * f; }
        {
            const int lo_ = opaque(lane); const int prod = wv >> 2, ti = (wv >> 1) & 1, tj = wv & 1, kr = lo_ & 31, hh = lo_ >> 5;
            const bf16_t* X = prod ? sQ : sK;
            f32x16 acc;
#pragma unroll
            for (int r = 0; r < 16; ++r) acc[r] = 0.f;
#pragma unroll
            for (int s = 0; s < 8; ++s) { const bf16x8 av = *(const bf16x8*)(X + (32 * ti + kr) * QS + 16 * s + 8 * hh); const bf16x8 bv = *(const bf16x8*)(sK + (32 * tj + kr) * QS + 16 * s + 8 * hh);
                acc = MFMA32(av, bv, acc); }
            const int j = 32 * tj + kr; const float gcj = s_gc[j];
#pragma unroll
            for (int r = 0; r < 16; ++r) { const int i = 32 * ti + (r & 3) + 8 * (r >> 2) + 4 * hh;
                const float dec = (i >= j) ? __expf(s_gc[i] - gcj) : 0.f;
                if (prod == 0) sA[i * AS + j] = (i > j) ? s_beta[i] * acc[r] * dec : 0.f;
                else gqk[(size_t)job * 4096 + i * 64 + (j & 32) + perm32(j & 31)] = f2bf(acc[r] * dec); }
        }
        __syncthreads();
        if (job + nb < 1024) PREP_LOAD(job + nb);
        {
            const int lo_ = opaque(lane); const int g = lo_ >> 4, c16 = lo_ & 15;
#pragma unroll 1
            for (int bb = 0; bb < 4; ++bb) {
                if (bb > 0) {
#pragma unroll
                    for (int t2 = 0; t2 < 2; ++t2) {
                        const int colbase = 32 * wv + 16 * t2; float* Xc = (colbase < 128) ? (sV + colbase) : (sW + (colbase - 128));
                        f32x4 acc;
#pragma unroll
                        for (int i = 0; i < 4; ++i) acc[i] = Xc[(16 * bb + 4 * g + i) * 129 + c16];
                        for (int c = 0; c < bb; ++c)
#pragma unroll
                            for (int s = 0; s < 4; ++s) {
                                const float av = -sA[(16 * bb + c16) * AS + 16 * c + 4 * s + g];
                                const float bv = Xc[(16 * c + 4 * s + g) * 129 + c16];
                                acc = __builtin_amdgcn_mfma_f32_16x16x4f32(av, bv, acc, 0, 0, 0);
                            }
#pragma unroll
                        for (int i = 0; i < 4; ++i) Xc[(16 * bb + 4 * g + i) * 129 + c16] = acc[i];
                    }
                    LDS_BARRIER();
                }
                if (tid < 256) {
                    float* colp = ((tid < 128) ? (sV + tid) : (sW + (tid - 128))) + 16 * bb * 129;
                    const float* sAo = sA + opaque(0) + (16 * bb) * AS + 16 * bb;
                    float x[16];
#pragma unroll
                    for (int i = 0; i < 16; ++i) {
                        float s = colp[i * 129];
#pragma unroll
                        for (int j4 = 0; j4 < (i + 3) / 4; ++j4) { const f32x4 av = *(const f32x4*)(sAo + i * AS + 4 * j4);
#pragma unroll
                            for (int q = 0; q < 4; ++q) if (4 * j4 + q < i) s -= av[q] * x[4 * j4 + q]; }
                        x[i] = s; colp[i * 129] = s;
                    }
                }
                LDS_BARRIER();
            }
        }
        const float glast = s_gc[63];
        if (tid < 64) s_g[tid] = __expf(glast - s_gc[tid]);
        LDS_BARRIER();
        if (tid < 256) {
            const int c = tid >> 2, s = tid & 3; unsigned o[16];
#pragma unroll
            for (int pp = 0; pp < 16; ++pp) { const int p0 = 2 * pp, j0 = p0 & 7, g0 = p0 >> 3, d0 = 16 * (j0 >> 2) + 4 * g0 + (j0 & 3);
                o[pp] = pack2(-sW[c * 129 + 32 * s + d0], -sW[c * 129 + 32 * s + d0 + 1]); }
            uint4* dp = (uint4*)(gnegw + (size_t)job * 8192 + c * 128 + 32 * s);
#pragma unroll
            for (int q = 0; q < 4; ++q) dp[q] = make_uint4(o[4 * q], o[4 * q + 1], o[4 * q + 2], o[4 * q + 3]);
        } else {
            const int t2 = tid - 256, c = t2 >> 2, s = t2 & 3; const float eg = s_eg[c]; unsigned o[16];
#pragma unroll
            for (int pp = 0; pp < 16; ++pp) { const int p0 = 2 * pp, j0 = p0 & 7, g0 = p0 >> 3, d0 = 16 * (j0 >> 2) + 4 * g0 + (j0 & 3);
                o[pp] = pack2(bf2f(sQ[c * QS + 32 * s + d0]) * eg, bf2f(sQ[c * QS + 32 * s + d0 + 1]) * eg); }
            uint4* dp = (uint4*)(gqd + (size_t)job * 8192 + c * 128 + 32 * s);
#pragma unroll
            for (int q = 0; q < 4; ++q) dp[q] = make_uint4(o[4 * q], o[4 * q + 1], o[4 * q + 2], o[4 * q + 3]);
        }
        if (tid < 256) {
            const int d = tid >> 1, s = tid & 1; unsigned o[16];
#pragma unroll
            for (int pp = 0; pp < 16; ++pp) { const int p0 = 2 * pp, j0 = p0 & 7, g0 = p0 >> 3, c0 = 32 * s + 16 * (j0 >> 2) + 4 * g0 + (j0 & 3);
                o[pp] = pack2(bf2f(sK[c0 * QS + d]) * s_g[c0], bf2f(sK[(c0 + 1) * QS + d]) * s_g[c0 + 1]); }
            uint4* dp = (uint4*)(gkdt + (size_t)job * 8192 + d * 64 + 32 * s);
#pragma unroll
            for (int q = 0; q < 4; ++q) dp[q] = make_uint4(o[4 * q], o[4 * q + 1], o[4 * q + 2], o[4 * q + 3]);
        } else {
            const int t2 = tid - 256, d = t2 >> 1, s = t2 & 1; unsigned o[16];
#pragma unroll
            for (int pp = 0; pp < 16; ++pp) o[pp] = pack2(sV[(32 * s + 2 * pp) * 129 + d], sV[(32 * s + 2 * pp + 1) * 129 + d]);
            uint4* dp = (uint4*)(gut + (size_t)job * 8192 + d * 64 + 32 * s);
#pragma unroll
            for (int q = 0; q < 4; ++q) dp[q] = make_uint4(o[4 * q], o[4 * q + 1], o[4 * q + 2], o[4 * q + 3]);
        }
        if (tid == 0) egl[job] = __expf(glast);
        __syncthreads();
    }
#undef PREP_LOAD
}

constexpr int GW = 136, GK = 72, GO = 132;
constexpr int GU = 72;
constexpr int GSCAN_BUF = (64 * GW + 128 * GK + 128 * GU) * 2;
__device__ __forceinline__ void phase_gdn_scan(const Params& p, int bh, unsigned char* smem) {
    const bf16_t* gnegw = (const bf16_t*)(p.ws + OFF_GNEGW); const bf16_t* gkdt = (const bf16_t*)(p.ws + OFF_GKDT);
    const bf16_t* gut = (const bf16_t*)(p.ws + OFF_GUT2); const float* egl = (const float*)(p.ws + OFF_EGL);
    uint4* gsb = (uint4*)(p.ws + OFF_GSB); uint4* gvb = (uint4*)(p.ws + OFF_GVB);
    const int tid = opaque((int)threadIdx.x), lane = tid & 63, wv = tid >> 6, g = lane >> 4, c16 = lane & 15, e = wv * 16 + c16;
    const int r1 = tid >> 4, k1 = (tid & 15) * 8;
    const int r2 = tid >> 3, k2 = (tid & 7) * 8;
    uint4 Aw0, Aw1, Ak0, Ak1, Au0, Au1, Bw0, Bw1, Bk0, Bk1, Bu0, Bu1;
#define GDN_LOAD(X, job) do { const size_t o_ = (size_t)(job) * 8192; \
        X##w0 = *(const uint4*)(gnegw + o_ + r1 * 128 + k1); X##w1 = *(const uint4*)(gnegw + o_ + (r1 + 32) * 128 + k1); \
        X##k0 = *(const uint4*)(gkdt + o_ + r2 * 64 + k2); X##k1 = *(const uint4*)(gkdt + o_ + (r2 + 64) * 64 + k2); \
        X##u0 = *(const uint4*)(gut + o_ + r2 * 64 + k2); X##u1 = *(const uint4*)(gut + o_ + (r2 + 64) * 64 + k2); } while (0)
#define GDN_STORE(X, bufi) do { bf16_t* sWn_ = (bf16_t*)(smem + (bufi) * GSCAN_BUF); bf16_t* sKd_ = sWn_ + 64 * GW; bf16_t* sU_ = sKd_ + 128 * GK; \
        *(uint4*)(sWn_ + r1 * GW + k1) = X##w0; *(uint4*)(sWn_ + (r1 + 32) * GW + k1) = X##w1; \
        *(uint4*)(sKd_ + r2 * GK + k2) = X##k0; *(uint4*)(sKd_ + (r2 + 64) * GK + k2) = X##k1; \
        *(uint4*)(sU_ + r2 * GU + k2) = X##u0; *(uint4*)(sU_ + (r2 + 64) * GU + k2) = X##u1; } while (0)
    f32x4 S[8];
#pragma unroll
    for (int i = 0; i < 8; ++i) S[i] = (f32x4){0.f, 0.f, 0.f, 0.f};
    GDN_LOAD(A, bh * 64);
    GDN_STORE(A, 0);
    GDN_LOAD(B, bh * 64 + 1); GDN_LOAD(A, bh * 64 + 2);
    __syncthreads();
#define GDN_STEP(n, X) do { \
        const int job = bh * 64 + (n); \
        if ((n) + 1 < 64) { GDN_STORE(X, ((n) + 1) & 1); if ((n) + 3 < 64) GDN_LOAD(X, job + 3); } \
        const bf16_t* sWn = (const bf16_t*)(smem + ((n) & 1) * GSCAN_BUF); const bf16_t* sKd = sWn + 64 * GW; const bf16_t* sU = sKd + 128 * GK; \
        f32x4 vacc[4]; \
        _Pragma("unroll") for (int ct = 0; ct < 4; ++ct) { const uint2 uu = *(const uint2*)(sU + e * GU + 16 * ct + 4 * g); \
            vacc[ct] = (f32x4){bf2f((bf16_t)(uu.x & 0xffff)), bf2f((bf16_t)(uu.x >> 16)), bf2f((bf16_t)(uu.y & 0xffff)), bf2f((bf16_t)(uu.y >> 16))}; } \
        const float eg = egl[job]; \
        bf16x8 sB[4]; \
        _Pragma("unroll") for (int s = 0; s < 4; ++s) { const uint4 tq = make_uint4(pack2(S[2 * s][0], S[2 * s][1]), pack2(S[2 * s][2], S[2 * s][3]), \
            pack2(S[2 * s + 1][0], S[2 * s + 1][1]), pack2(S[2 * s + 1][2], S[2 * s + 1][3])); sB[s] = __builtin_bit_cast(bf16x8, tq); \
            gsb[((size_t)(job * 8 + wv) * 4 + s) * 64 + lane] = tq; } \
        _Pragma("unroll") for (int ct = 0; ct < 4; ++ct) _Pragma("unroll") for (int s = 0; s < 4; ++s) { \
                const bf16x8 aw = *(const bf16x8*)(sWn + (16 * ct + c16) * GW + 32 * s + 8 * g); \
                vacc[ct] = __builtin_amdgcn_mfma_f32_16x16x32_bf16(aw, sB[s], vacc[ct], 0, 0, 0); } \
        bf16x8 vB[2]; \
        _Pragma("unroll") for (int s = 0; s < 2; ++s) { const uint4 tq = make_uint4(pack2(vacc[2 * s][0], vacc[2 * s][1]), pack2(vacc[2 * s][2], vacc[2 * s][3]), \
            pack2(vacc[2 * s + 1][0], vacc[2 * s + 1][1]), pack2(vacc[2 * s + 1][2], vacc[2 * s + 1][3])); vB[s] = __builtin_bit_cast(bf16x8, tq); \
            gvb[((size_t)(job * 8 + wv) * 2 + s) * 64 + lane] = tq; } \
        _Pragma("unroll") for (int dt = 0; dt < 8; ++dt) { S[dt] *= eg; \
            _Pragma("unroll") for (int s = 0; s < 2; ++s) { \
                const bf16x8 a = *(const bf16x8*)(sKd + (16 * dt + c16) * GK + 32 * s + 8 * g); \
                S[dt] = __builtin_amdgcn_mfma_f32_16x16x32_bf16(a, vB[s], S[dt], 0, 0, 0); } } \
        LDS_BARRIER(); \
    } while (0)
    for (int n = 0; n < 64; n += 2) { GDN_STEP(n, B); GDN_STEP(n + 1, A); }
#undef GDN_LOAD
#undef GDN_STORE
#undef GDN_STEP
}

__device__ __forceinline__ void phase_gdn_out(const Params& p, int bid, int nb, unsigned char* smem) {
    bf16_t* sQd = (bf16_t*)smem; bf16_t* sQK = sQd + 64 * GW; bf16_t* sG = sQK + 64 * GK; float* sO = (float*)(sG + 64 * GW); float* sNW = sO + 64 * GO;
    const bf16_t* proj = (const bf16_t*)(p.ws + OFF_PROJ); const bf16_t* gqd = (const bf16_t*)(p.ws + OFF_GQD); const bf16_t* gqk = (const bf16_t*)(p.ws + OFF_GQK);
    const uint4* gsb = (const uint4*)(p.ws + OFF_GSB); const uint4* gvb = (const uint4*)(p.ws + OFF_GVB);
    bf16_t* ycat = (bf16_t*)(p.ws + OFF_YCAT);
    const int tid = opaque((int)threadIdx.x), lane = tid & 63, wv = tid >> 6, g = lane >> 4, c16 = lane & 15, e = wv * 16 + c16;
    const int r1 = tid >> 4, k1 = (tid & 15) * 8, r2 = tid >> 3, k2 = (tid & 7) * 8, ec = tid >> 3, ee = (tid & 7) * 16;
    if (tid < 128) sNW[tid] = p.gdn_norm_w[tid];
    for (int job = bid; job < 1024; job += nb) {
        const int bh = job >> 6, n = job & 63, b = bh >> 3, h = bh & 7;
        const size_t o_ = (size_t)job * 8192; const bf16_t* gp_ = proj + (size_t)(b * T + n * 64) * PROJ_LD + C_GATEG + h * 128;
        const uint4 q0 = *(const uint4*)(gqd + o_ + r1 * 128 + k1), q1 = *(const uint4*)(gqd + o_ + (r1 + 32) * 128 + k1), qk = *(const uint4*)(gqk + (size_t)job * 4096 + r2 * 64 + k2);
        const uint4 g0 = *(const uint4*)(gp_ + (size_t)r1 * PROJ_LD + k1), g1 = *(const uint4*)(gp_ + (size_t)(r1 + 32) * PROJ_LD + k1);
        bf16x8 sB[4], vB[2];
#pragma unroll
        for (int s = 0; s < 4; ++s) { const uint4 tq = gsb[((size_t)(job * 8 + wv) * 4 + s) * 64 + lane]; sB[s] = __builtin_bit_cast(bf16x8, tq); }
#pragma unroll
        for (int s = 0; s < 2; ++s) { const uint4 tq = gvb[((size_t)(job * 8 + wv) * 2 + s) * 64 + lane]; vB[s] = __builtin_bit_cast(bf16x8, tq); }
        __syncthreads();
        *(uint4*)(sQd + r1 * GW + k1) = q0; *(uint4*)(sQd + (r1 + 32) * GW + k1) = q1; *(uint4*)(sQK + r2 * GK + k2) = qk;
        *(uint4*)(sG + r1 * GW + k1) = g0; *(uint4*)(sG + (r1 + 32) * GW + k1) = g1;
        __syncthreads();
        f32x4 oacc[4];
#pragma unroll
        for (int ct = 0; ct < 4; ++ct) { oacc[ct] = (f32x4){0.f, 0.f, 0.f, 0.f};
#pragma unroll
            for (int s = 0; s < 4; ++s) { const bf16x8 aq = *(const bf16x8*)(sQd + (16 * ct + c16) * GW + 32 * s + 8 * g); oacc[ct] = __builtin_amdgcn_mfma_f32_16x16x32_bf16(aq, sB[s], oacc[ct], 0, 0, 0); }
#pragma unroll
            for (int s = 0; s < 2; ++s) { const bf16x8 a = *(const bf16x8*)(sQK + (16 * ct + c16) * GK + 32 * s + 8 * g); oacc[ct] = __builtin_amdgcn_mfma_f32_16x16x32_bf16(a, vB[s], oacc[ct], 0, 0, 0); } }
#pragma unroll
        for (int ct = 0; ct < 4; ++ct)
#pragma unroll
            for (int i = 0; i < 4; ++i) sO[(16 * ct + 4 * g + i) * GO + e] = oacc[ct][i];
        __syncthreads();
        {
            f32x4 o[4]; float ss = 0.f;
#pragma unroll
            for (int q = 0; q < 4; ++q) { o[q] = *(const f32x4*)(sO + ec * GO + ee + 4 * q); ss += o[q][0] * o[q][0] + o[q][1] * o[q][1] + o[q][2] * o[q][2] + o[q][3] * o[q][3]; }
            ss += __shfl_xor(ss, 1); ss += __shfl_xor(ss, 2); ss += __shfl_xor(ss, 4);
            const float rstd = rsqrtf(ss * (1.f / 128.f) + 1e-6f);
            const uint4 gq0 = *(const uint4*)(sG + ec * GW + ee), gq1 = *(const uint4*)(sG + ec * GW + ee + 8);
            unsigned yo[8];
#pragma unroll
            for (int q = 0; q < 8; ++q) { const unsigned gwq = (q == 0) ? gq0.x : (q == 1) ? gq0.y : (q == 2) ? gq0.z : (q == 3) ? gq0.w : (q == 4) ? gq1.x : (q == 5) ? gq1.y : (q == 6) ? gq1.z : gq1.w;
                const float ga = bf2f((bf16_t)(gwq & 0xffff)), gb = bf2f((bf16_t)(gwq >> 16)); const f32x4 nwv = *(const f32x4*)(sNW + ee + 4 * (q >> 1));
                const float y0 = o[q >> 1][(q & 1) * 2] * rstd * nwv[(q & 1) * 2] * silu_f(ga), y1 = o[q >> 1][(q & 1) * 2 + 1] * rstd * nwv[(q & 1) * 2 + 1] * silu_f(gb);
                yo[q] = pack2(y0, y1); }
            uint4* yp = (uint4*)(ycat + (size_t)(b * T + n * 64 + ec) * D + h * 128 + ee);
            yp[0] = make_uint4(yo[0], yo[1], yo[2], yo[3]); yp[1] = make_uint4(yo[4], yo[5], yo[6], yo[7]);
        }
    }
    __syncthreads();
}

constexpr int OS = 136;
constexpr int NSA_KV = 16384;
constexpr float NSA_SC2 = 0.08838834764831845f * 1.4426950408889634f;
typedef short s16x4 __attribute__((ext_vector_type(4)));

__device__ __forceinline__ void nsa_stage(const bf16_t* Kg, const bf16_t* Vg, int ld, unsigned char* smem, int buf) {
    const int tid = opaque((int)threadIdx.x), L = tid & 63, wvu = __builtin_amdgcn_readfirstlane(tid >> 6);
#pragma unroll
    for (int i = 0; i < 2; ++i) {
        const int row = 8 * wvu + 4 * i + (L >> 4), pos = L & 15, ch = pos ^ (((row & 3) << 2) | ((row >> 2) & 3));
        const size_t go = (size_t)row * ld + ch * 8;
        __builtin_amdgcn_global_load_lds((const unsigned*)(Kg + go), (LAS unsigned*)(smem + buf + wvu * 2048 + i * 1024), 16, 0, 0);
        __builtin_amdgcn_global_load_lds((const unsigned*)(Vg + go), (LAS unsigned*)(smem + buf + NSA_KV + wvu * 2048 + i * 1024), 16, 0, 0);
    }
}
__device__ __forceinline__ void nsa_scores(const unsigned char* sK, const bf16x8 (&bq)[8], f32x16& s0, f32x16& s1, int lane) {
    lane = opaque(lane); const int kr = lane & 31, h = lane >> 5, xr = ((kr & 3) << 2) | ((kr >> 2) & 3);
    const unsigned char* rp = sK + 256 * kr;
#pragma unroll
    for (int i = 0; i < 16; ++i) { s0[i] = 0.f; s1[i] = 0.f; }
#pragma unroll
    for (int s = 0; s < 8; ++s) {
        const int o = 16 * ((2 * s + h) ^ xr);
        const bf16x8 a0 = *(const bf16x8*)(rp + o);
        const bf16x8 a1 = *(const bf16x8*)(rp + 8192 + o);
        s0 = MFMA32(a0, bq[s], s0); s1 = MFMA32(a1, bq[s], s1);
        if (s & 1) __builtin_amdgcn_sched_barrier(0);
    }
}
__device__ __forceinline__ void nsa_pv_sel(const unsigned char* sV, const f32x16& p0, const f32x16& p1, f32x16 (&oacc)[4], unsigned pmask, int lane) {
    lane = opaque(lane); const int h = lane >> 5, blk = (lane >> 4) & 1, q = (lane & 15) >> 2, pp = lane & 3;
    const int base = 1024 * h + 256 * q + 8 * (pp & 1), lowv = 2 * blk + (pp >> 1);
#pragma unroll
    for (int s = 0; s < 4; ++s) { union { bf16x8 v; unsigned u[4]; } t;
#pragma unroll
        for (int j = 0; j < 4; ++j) { const int r = 8 * (s & 1) + 2 * j; t.u[j] = ((s < 2) ? pack2(p0[r], p0[r + 1]) : pack2(p1[r], p1[r + 1])) & pmask; }
#pragma unroll
        for (int dt = 0; dt < 4; ++dt) {
            union { bf16x8 v; s16x4 hlf[2]; } a;
#pragma unroll
            for (int tt = 0; tt < 2; ++tt) { const int ad = base + 4096 * s + 2048 * tt + 64 * (dt ^ q) + 16 * (lowv ^ (2 * tt + h));
                a.hlf[tt] = __builtin_amdgcn_ds_read_tr16_b64_v4i16((LAS s16x4*)(sV + ad)); }
            oacc[dt] = MFMA32(a.v, t.v, oacc[dt]);
        }
        __builtin_amdgcn_sched_barrier(0); }
}
__device__ __forceinline__ void nsa_pv(const unsigned char* sV, const f32x16& p0, const f32x16& p1, f32x16 (&oacc)[4], int lane) { nsa_pv_sel(sV, p0, p1, oacc, 0xffffffffu, lane); }
template <class VF>
__device__ __forceinline__ void nsa_tile_online(const unsigned char* sK, const unsigned char* sV, const bf16x8 (&bq)[8], f32x16 (&oacc)[4], float& m, float& l, const VF& valid, int lane) {
    const int h = opaque(lane) >> 5;
    f32x16 s0, s1;
    nsa_scores(sK, bq, s0, s1, lane);
    float mx = -1e30f;
#pragma unroll
    for (int r = 0; r < 16; ++r) { const int key = (r & 3) + 8 * (r >> 2) + 4 * h;
        s0[r] = valid(key) ? s0[r] * NSA_SC2 : -1e30f; s1[r] = valid(key + 32) ? s1[r] * NSA_SC2 : -1e30f;
        mx = fmaxf(mx, fmaxf(s0[r], s1[r])); }
    mx = fmaxf(mx, __shfl_xor(mx, 32));
    const float mn = fmaxf(m, mx);
    const float alpha = __builtin_amdgcn_exp2f(m - mn);
    float ps = 0.f;
#pragma unroll
    for (int r = 0; r < 16; ++r) {
        s0[r] = (s0[r] > -1e29f) ? __builtin_amdgcn_exp2f(s0[r] - mn) : 0.f;
        s1[r] = (s1[r] > -1e29f) ? __builtin_amdgcn_exp2f(s1[r] - mn) : 0.f;
        ps += s0[r] + s1[r]; }
    l = l * alpha + ps; m = mn;
#pragma unroll
    for (int dt = 0; dt < 4; ++dt)
#pragma unroll
        for (int r = 0; r < 16; ++r) oacc[dt][r] *= alpha;
    nsa_pv(sV, s0, s1, oacc, lane);
}
__device__ __forceinline__ void nsa_tile_fast(const unsigned char* sK, const unsigned char* sV, const bf16x8 (&bq)[8], f32x16 (&oacc)[4], float& m, float& l, bool rowsel, int lane) {
    f32x16 s0, s1;
    nsa_scores(sK, bq, s0, s1, lane);
    float mx = fmaxf(s0[0], s1[0]);
#pragma unroll
    for (int r = 1; r < 16; ++r) mx = fmaxf(mx, fmaxf(s0[r], s1[r]));
    mx = fmaxf(mx, __shfl_xor(mx, 32)) * NSA_SC2;
    if (__any(mx > m + 8.f)) {
        const float mn = (mx > m + 8.f) ? mx : m;
        const float alpha = __builtin_amdgcn_exp2f(m - mn);
        m = mn; l *= alpha;
#pragma unroll
        for (int dt = 0; dt < 4; ++dt)
#pragma unroll
            for (int r = 0; r < 16; ++r) oacc[dt][r] *= alpha;
    }
    float ps = 0.f;
#pragma unroll
    for (int r = 0; r < 16; ++r) { s0[r] = __builtin_amdgcn_exp2f(fmaf(s0[r], NSA_SC2, -m)); s1[r] = __builtin_amdgcn_exp2f(fmaf(s1[r], NSA_SC2, -m)); ps += s0[r] + s1[r]; }
    l += rowsel ? ps : 0.f;
    nsa_pv_sel(sV, s0, s1, oacc, rowsel ? 0xffffffffu : 0u, lane);
}
__device__ __forceinline__ void nsa_flush(bf16_t* yrow, const f32x16 (&oacc)[4], float f, bool first, int lane) {
    const int h = opaque(lane) >> 5;
#pragma unroll
    for (int dt = 0; dt < 4; ++dt)
#pragma unroll
        for (int rr = 0; rr < 4; ++rr) {
            bf16_t* dp = yrow + 32 * dt + 8 * rr + 4 * h;
            float v[4];
#pragma unroll
            for (int i = 0; i < 4; ++i) v[i] = oacc[dt][4 * rr + i] * f;
            if (!first) { const uint2 o = *(const uint2*)dp; v[0] += bf2f((bf16_t)(o.x & 0xffff)); v[1] += bf2f((bf16_t)(o.x >> 16)); v[2] += bf2f((bf16_t)(o.y & 0xffff)); v[3] += bf2f((bf16_t)(o.y >> 16)); }
            uint2 o; o.x = pack2(v[0], v[1]); o.y = pack2(v[2], v[3]); *(uint2*)dp = o;
        }
}

constexpr int NSA_BUF = 2 * NSA_KV;
#define NSA_WAIT(ahead) do { if ((ahead) >= 2) asm volatile("s_waitcnt vmcnt(8)" ::: "memory"); else if ((ahead) == 1) asm volatile("s_waitcnt vmcnt(4)" ::: "memory"); \
        else asm volatile("s_waitcnt vmcnt(0)" ::: "memory"); LDS_BARRIER(); } while (0)

__device__ __forceinline__ void nsa_job(const Params& p, int job, unsigned char* smem) {
    float* sImp = (float*)(smem + 4 * NSA_BUF); unsigned* sMask = (unsigned*)(sImp + 64 * 64);
    const bf16_t* proj = (const bf16_t*)(p.ws + OFF_PROJ); const float* small = (const float*)(p.ws + OFF_SMALL);
    const bf16_t* kc = (const bf16_t*)(p.ws + OFF_KVC); const bf16_t* vc = kc + 1024 * 128;
    const int tid = opaque((int)threadIdx.x), lane = tid & 63, wv = tid >> 6, h = lane >> 5, ql = lane & 31, tl = ql >> 2, gh = ql & 3;
    const int b = job >> 7, kvh = (job >> 6) & 1, qt = job & 63, t0 = qt * 64;
    const int tq = t0 + 8 * wv + tl;
    const size_t qrow = (size_t)(b * T + tq);
    const int head = kvh * 4 + gh;
    bf16_t* yrow = (bf16_t*)(p.ws + OFF_YCAT) + qrow * D + 1024 + head * 128;
    const int nct = (((t0 + 32) >> 4) >> 6) + 1;
    const bf16_t* kcb = kc + (size_t)(b * 512 + kvh * 256) * 128; const bf16_t* vcb = vc + (size_t)(b * 512 + kvh * 256) * 128;
    const bf16_t* pb = proj + (size_t)(b * T) * PROJ_LD + kvh * 128;
    const int jw0 = qt > 8 ? qt - 8 : 0;
    int nis, ncomp;
    __syncthreads();
    bf16x8 bq[8];
#pragma unroll
    for (int s = 0; s < 8; ++s) bq[s] = *(const bf16x8*)(proj + qrow * PROJ_LD + C_QN + head * 128 + 16 * s + 8 * h);
    f32x16 oacc[4];
    float m = -1e30f, l = 0.f;
    nis = 0; ncomp = 0;
    for (; nis < 3 && nis < nct; ++nis) nsa_stage(kcb + (size_t)nis * 64 * 128, vcb + (size_t)nis * 64 * 128, 128, smem, (nis & 3) * NSA_BUF);
    for (int ct = 0; ct < nct; ++ct) {
        NSA_WAIT(nis - ncomp - 1);
        const unsigned char* sK = smem + (ncomp & 3) * NSA_BUF; ++ncomp;
        if (nis < nct) { nsa_stage(kcb + (size_t)nis * 64 * 128, vcb + (size_t)nis * 64 * 128, 128, smem, (nis & 3) * NSA_BUF); ++nis; }
        f32x16 s0, s1; nsa_scores(sK, bq, s0, s1, lane);
        float mx = -1e30f; const int hh = opaque(lane) >> 5;
#pragma unroll
        for (int r = 0; r < 16; ++r) { const int c = ct * 64 + (r & 3) + 8 * (r >> 2) + 4 * hh;
            s0[r] = (c * 16 + 31 <= tq) ? s0[r] * NSA_SC2 : -1e30f; s1[r] = ((c + 32) * 16 + 31 <= tq) ? s1[r] * NSA_SC2 : -1e30f; mx = fmaxf(mx, fmaxf(s0[r], s1[r])); }
        mx = fmaxf(mx, __shfl_xor(mx, 32));
        const float mn = fmaxf(m, mx); float ps = 0.f;
#pragma unroll
        for (int r = 0; r < 16; ++r) { ps += (s0[r] > -1e29f) ? __builtin_amdgcn_exp2f(s0[r] - mn) : 0.f; ps += (s1[r] > -1e29f) ? __builtin_amdgcn_exp2f(s1[r] - mn) : 0.f; }
        l = l * __builtin_amdgcn_exp2f(m - mn) + ps; m = mn;
    }
    l += __shfl_xor(l, 32);
    const float linv = l > 0.f ? 1.f / l : 0.f;
#pragma unroll
    for (int dt = 0; dt < 4; ++dt)
#pragma unroll
        for (int r = 0; r < 16; ++r) oacc[dt][r] = 0.f;
    float carry = 0.f;
    LDS_BARRIER();
    nis = 0; ncomp = 0;
    for (; nis < 3 && nis < nct; ++nis) nsa_stage(kcb + (size_t)nis * 64 * 128, vcb + (size_t)nis * 64 * 128, 128, smem, (nis & 3) * NSA_BUF);
    for (int ct = 0; ct < 4; ++ct) {
        if (ct < nct) {
            NSA_WAIT(nis - ncomp - 1);
            const unsigned char* sK = smem + (ncomp & 3) * NSA_BUF; ++ncomp;
            if (nis < nct) { nsa_stage(kcb + (size_t)nis * 64 * 128, vcb + (size_t)nis * 64 * 128, 128, smem, (nis & 3) * NSA_BUF); ++nis; }
            f32x16 s0, s1; nsa_scores(sK, bq, s0, s1, lane); const int hh = opaque(lane) >> 5;
#pragma unroll
            for (int r = 0; r < 16; ++r) { const int c = ct * 64 + (r & 3) + 8 * (r >> 2) + 4 * hh;
                s0[r] = (c * 16 + 31 <= tq) ? __builtin_amdgcn_exp2f(s0[r] * NSA_SC2 - m) * linv : 0.f;
                s1[r] = ((c + 32) * 16 + 31 <= tq) ? __builtin_amdgcn_exp2f(s1[r] * NSA_SC2 - m) * linv : 0.f; }
#pragma unroll
            for (int mt = 0; mt < 2; ++mt)
#pragma unroll
                for (int rr = 0; rr < 4; ++rr) {
                    const float G = (mt ? s1[4 * rr] : s0[4 * rr]) + (mt ? s1[4 * rr + 1] : s0[4 * rr + 1]) + (mt ? s1[4 * rr + 2] : s0[4 * rr + 2]) + (mt ? s1[4 * rr + 3] : s0[4 * rr + 3]);
                    const float mine_last = mt ? s1[4 * rr + 3] : s0[4 * rr + 3];
                    const float prev_last = (rr > 0) ? (mt ? s1[4 * rr - 1] : s0[4 * rr - 1]) : (mt ? s0[15] : carry);
                    const float send = h ? prev_last : mine_last;
                    float v = G + __shfl_xor(send, 32);
                    v += __shfl_xor(v, 1); v += __shfl_xor(v, 2);
                    if (gh == 0) sImp[(wv * 8 + tl) * 64 + 16 * ct + 8 * mt + 2 * rr + h] = v;
                }
            carry = s1[15];
            nsa_pv(sK + NSA_KV, s0, s1, oacc, lane);
        } else {
            if (gh == 0) {
#pragma unroll
                for (int q = 0; q < 8; ++q) sImp[(wv * 8 + tl) * 64 + 16 * ct + 2 * q + h] = 0.f;
            }
        }
    }
    LDS_BARRIER();
    nis = 0; ncomp = 0;
    { int wi = jw0; for (; nis < 3 && wi <= qt; ++nis, ++wi) nsa_stage(pb + (size_t)(wi * 64) * PROJ_LD + C_KWIN, pb + (size_t)(wi * 64) * PROJ_LD + C_VWIN, PROJ_LD, smem, (nis & 3) * NSA_BUF); }
    nsa_flush(yrow, oacc, sigmoid_f(small[qrow * 64 + 16 + head]), true, lane);
    {
        const int lo_ = opaque(lane); const int tk = lo_ >> 3, sub = lo_ & 7;
        unsigned lo = 0u, hi = 0u;
        if (qt < 16) { lo = (1u << (qt + 1)) - 1u; }
        else {
            const float* ip = sImp + (wv * 8 + tk) * 64;
            unsigned bits = 0u;
            for (int i = 0; i < 8; ++i) { const int j = sub * 8 + i; const float v = ip[j]; int rank = 0;
                for (int j2 = 1; j2 <= qt - 2; ++j2) { const float v2 = ip[j2]; rank += (v2 > v || (v2 == v && j2 < j)) ? 1 : 0; }
                if (j >= 1 && j <= qt - 2 && rank < 13) bits |= 1u << i; }
            if (sub < 4) lo = bits << (8 * sub); else hi = bits << (8 * (sub - 4));
            lo |= __shfl_xor(lo, 1); hi |= __shfl_xor(hi, 1); lo |= __shfl_xor(lo, 2); hi |= __shfl_xor(hi, 2); lo |= __shfl_xor(lo, 4); hi |= __shfl_xor(hi, 4);
            lo |= 1u;
            if (qt < 32) lo |= 1u << qt; else hi |= 1u << (qt - 32);
            if (qt - 1 < 32) lo |= 1u << (qt - 1); else hi |= 1u << (qt - 33);
        }
        if (sub == 0) { sMask[(wv * 8 + tk) * 2] = lo; sMask[(wv * 8 + tk) * 2 + 1] = hi; }
    }
    LDS_BARRIER();
    const unsigned long long mymask = (unsigned long long)sMask[(wv * 8 + tl) * 2] | ((unsigned long long)sMask[(wv * 8 + tl) * 2 + 1] << 32);
    unsigned long long un;
    { unsigned lo = sMask[lane * 2], hi = sMask[lane * 2 + 1];
#pragma unroll
      for (int o = 32; o > 0; o >>= 1) { lo |= __shfl_xor(lo, o); hi |= __shfl_xor(hi, o); }
      un = (unsigned long long)(unsigned)__builtin_amdgcn_readfirstlane((int)lo) | ((unsigned long long)(unsigned)__builtin_amdgcn_readfirstlane((int)hi) << 32); }
#pragma unroll
    for (int dt = 0; dt < 4; ++dt)
#pragma unroll
        for (int r = 0; r < 16; ++r) oacc[dt][r] = 0.f;
    m = -1e30f; l = 0.f;
    {
        int wi = jw0 + nis;
        for (int j = jw0; j <= qt; ++j) {
            NSA_WAIT(nis - ncomp - 1);
            const unsigned char* sK = smem + (ncomp & 3) * NSA_BUF; ++ncomp;
            if (wi <= qt) { nsa_stage(pb + (size_t)(wi * 64) * PROJ_LD + C_KWIN, pb + (size_t)(wi * 64) * PROJ_LD + C_VWIN, PROJ_LD, smem, (nis & 3) * NSA_BUF); ++nis; ++wi; }
            const int kbase = j * 64;
            if (j < qt && j >= qt - 7) nsa_tile_fast(sK, sK + NSA_KV, bq, oacc, m, l, true, lane);
            else nsa_tile_online(sK, sK + NSA_KV, bq, oacc, m, l, [&](int key) { const int kp = kbase + key; return kp <= tq && kp > tq - 512; }, lane);
        }
    }
    LDS_BARRIER();
    nis = 0; ncomp = 0;
    unsigned long long irem = un >> 1; int ij = 0; bool imore = true;
    for (; nis < 3 && imore; ++nis) {
        nsa_stage(pb + (size_t)(ij * 64) * PROJ_LD + C_KSLC, pb + (size_t)(ij * 64) * PROJ_LD + C_VSLC, PROJ_LD, smem, (nis & 3) * NSA_BUF);
        if (irem == 0ull) imore = false; else { const int z = __builtin_ctzll(irem); ij += 1 + z; irem = (z >= 63) ? 0ull : (irem >> (z + 1)); } }
    { const float lt = l + __shfl_xor(l, 32); nsa_flush(yrow, oacc, lt > 0.f ? sigmoid_f(small[qrow * 64 + 32 + head]) / lt : 0.f, false, lane); }
#pragma unroll
    for (int dt = 0; dt < 4; ++dt)
#pragma unroll
        for (int r = 0; r < 16; ++r) oacc[dt][r] = 0.f;
    m = -1e30f; l = 0.f;
    {
        unsigned long long rem = un >> 1; int j = 0;
        for (;;) {
            NSA_WAIT(nis - ncomp - 1);
            const unsigned char* sK = smem + (ncomp & 3) * NSA_BUF; ++ncomp;
            if (imore) { nsa_stage(pb + (size_t)(ij * 64) * PROJ_LD + C_KSLC, pb + (size_t)(ij * 64) * PROJ_LD + C_VSLC, PROJ_LD, smem, (nis & 3) * NSA_BUF); ++nis;
                if (irem == 0ull) imore = false; else { const int z = __builtin_ctzll(irem); ij += 1 + z; irem = (z >= 63) ? 0ull : (irem >> (z + 1)); } }
            const bool selj = (mymask >> j) & 1ull; const int kbase = j * 64;
            if (j < qt) nsa_tile_fast(sK, sK + NSA_KV, bq, oacc, m, l, selj, lane);
            else nsa_tile_online(sK, sK + NSA_KV, bq, oacc, m, l, [&](int key) { return selj && (kbase + key <= tq); }, lane);
            if (rem == 0ull) break;
            const int z = __builtin_ctzll(rem); j += 1 + z; rem = (z >= 63) ? 0ull : (rem >> (z + 1));
        }
    }
    { const float lt = l + __shfl_xor(l, 32); nsa_flush(yrow, oacc, lt > 0.f ? sigmoid_f(small[qrow * 64 + 24 + head]) / lt : 0.f, false, lane); }
}

constexpr size_t OFF_CPART = OFF_FLAT;
struct EpiPart { float* o; __device__ __forceinline__ void operator()(int row, int col, float v0, float v1) const { o[(size_t)row * 256 + col] = v0; o[(size_t)row * 256 + col + 32] = v1; } };
__device__ __forceinline__ void phase_cmp1(const Params& p, int bid, int nb, unsigned char* smem) {
    for (int j = bid; j < 256; j += nb) {
        const int ks = j & 7, nt = (j >> 3) & 1, mt = (j >> 4) & 7, which = j >> 7;
        ARowWin af{(const bf16_t*)(p.ws + OFF_PROJ), which ? C_VCMP : C_KCMP}; BRowDirect bf{(const bf16_t*)(p.ws + OFF_W1T) + (size_t)which * 256 * 4096, 4096};
        EpiPart e{(float*)(p.ws + OFF_CPART) + (size_t)(ks * 2 + which) * 1024 * 256};
        gemm_tile128(af, bf, ks * 512, 512, mt * 128, nt * 128, e, smem);
    }
}
constexpr int HS = 264;
__device__ __forceinline__ void phase_cmp2(const Params& p, int bid, int nb, unsigned char* smem) {
    bf16_t* sH = (bf16_t*)smem;
    const int tid = opaque((int)threadIdx.x), lane = tid & 63, wv = tid >> 6;
    for (int j = bid; j < 64; j += nb) {
        const int which = j >> 5, r0 = (j & 31) * 32;
        const float* part = (const float*)(p.ws + OFF_CPART) + (size_t)which * 1024 * 256; const float* bias = (const float*)(p.ws + OFF_BIAS1) + which * 256;
#pragma unroll
        for (int it = 0; it < 4; ++it) { const int id = tid + 512 * it, r = id >> 6, c4 = (id & 63) * 4;
            f32x4 s = *(const f32x4*)(bias + c4);
#pragma unroll
            for (int ks = 0; ks < 8; ++ks) s += *(const f32x4*)(part + (size_t)ks * 2 * 1024 * 256 + (size_t)(r0 + r) * 256 + c4);
            uint2 o; o.x = pack2(silu_f(s[0]), silu_f(s[1])); o.y = pack2(silu_f(s[2]), silu_f(s[3]));
            *(uint2*)(sH + r * HS + c4) = o; }
        __syncthreads();
        if (wv < 4) {
            const bf16_t* w2 = (const bf16_t*)(p.ws + OFF_W2T) + (size_t)which * 128 * 256;
            f32x16 acc;
#pragma unroll
            for (int r = 0; r < 16; ++r) acc[r] = 0.f;
#pragma unroll
            for (int s = 0; s < 16; ++s) { const bf16x8 av = *(const bf16x8*)(sH + (lane & 31) * HS + 16 * s + 8 * (lane >> 5));
                const bf16x8 bv = *(const bf16x8*)(w2 + (size_t)(32 * wv + (lane & 31)) * 256 + 16 * s + 8 * (lane >> 5));
                acc = MFMA32(av, bv, acc); }
            bf16_t* o = (bf16_t*)(p.ws + OFF_KVC) + (size_t)which * 1024 * 128;
#pragma unroll
            for (int r = 0; r < 16; ++r) o[(size_t)(r0 + (r & 3) + 8 * (r >> 2) + 4 * (lane >> 5)) * 128 + 32 * wv + (lane & 31)] = f2bf(acc[r]);
        }
        __syncthreads();
    }
}

constexpr int SHS = 2052;
__device__ __forceinline__ void phase_router(const Params& p, int bid, int nb, unsigned char* smem, int cnt_off = 0) {
    float* sh = (float*)smem;
    const float* x1 = (const float*)(p.ws + OFF_X1); const float* mod = (const float*)(p.ws + OFF_MOD);
    bf16_t* h2 = (bf16_t*)(p.ws + OFF_H);
    int* tkidx = (int*)(p.ws + OFF_TKIDX); float* tkw = (float*)(p.ws + OFF_TKW); int* slot = (int*)(p.ws + OFF_SLOT);
    unsigned* cnt = (unsigned*)(p.ws + OFF_CTRL) + CW_CNT + cnt_off;
    const int tid = opaque((int)threadIdx.x), lane = tid & 63, wv = tid >> 6;
    for (int batch = bid; batch < NTOK / 16; batch += nb) {
        const int r0 = batch * 16;
#pragma unroll
        for (int rr = 0; rr < 2; ++rr) {
            const int lr = wv * 2 + rr, row = r0 + lr, b = row / T;
            const float* xr = x1 + (size_t)row * D;
            f32x4 v[8]; float ss = 0.f;
#pragma unroll
            for (int c = 0; c < 8; ++c) { v[c] = *(const f32x4*)(xr + (c * 64 + lane) * 4); ss += v[c][0] * v[c][0] + v[c][1] * v[c][1] + v[c][2] * v[c][2] + v[c][3] * v[c][3]; }
            ss = wave_sum(ss);
            const float rstd = rsqrtf(ss * (1.f / D) + 1e-6f);
            const float* shf = mod + b * 12288 + 3 * 2048; const float* sc = mod + b * 12288 + 4 * 2048;
#pragma unroll
            for (int c = 0; c < 8; ++c) { const int col = (c * 64 + lane) * 4;
                const f32x4 w = *(const f32x4*)(p.norm_ffn_w + col), s1 = *(const f32x4*)(sc + col), s0 = *(const f32x4*)(shf + col);
                f32x4 o;
#pragma unroll
                for (int q = 0; q < 4; ++q) o[q] = v[c][q] * rstd * w[q] * (1.f + s1[q]) + s0[q];
                *(f32x4*)(sh + lr * SHS + col) = o;
                uint2 pk; pk.x = pack2(o[0], o[1]); pk.y = pack2(o[2], o[3]);
                *(uint2*)(h2 + (size_t)row * D + col) = pk; }
        }
        __syncthreads();
        f32x4 acc[4];
#pragma unroll
        for (int nt = 0; nt < 4; ++nt) acc[nt] = (f32x4){0.f, 0.f, 0.f, 0.f};
        {
            const float* ap = sh + (lane & 15) * SHS + 256 * wv + (lane >> 4);
            const float* bp = (const float*)(p.ws + OFF_RWP) + (size_t)(256 * wv + (lane >> 4)) * 64 + 4 * (lane & 15);
#pragma unroll 8
            for (int s = 0; s < 64; ++s) {
                const float av = ap[4 * s];
                const f32x4 bv = *(const f32x4*)(bp + (size_t)s * 256);
#pragma unroll
                for (int nt = 0; nt < 4; ++nt) acc[nt] = __builtin_amdgcn_mfma_f32_16x16x4f32(av, bv[nt], acc[nt], 0, 0, 0);
            }
        }
        __syncthreads();
#pragma unroll
        for (int nt = 0; nt < 4; ++nt)
#pragma unroll
            for (int i = 0; i < 4; ++i) sh[(wv * 16 + 4 * (lane >> 4) + i) * 64 + 16 * nt + (lane & 15)] = acc[nt][i];
        __syncthreads();
        const float bias = p.router_bias[lane];
        unsigned* lcnt = (unsigned*)(sh + 8 * 16 * 64);
        if (tid < 64) lcnt[tid] = 0u;
        __syncthreads();
        int rnk[2]; unsigned loc[2];
#pragma unroll
        for (int rr = 0; rr < 2; ++rr) {
            const int lr = wv * 2 + rr, row = r0 + lr;
            float lg = 0.f;
#pragma unroll
            for (int w = 0; w < 8; ++w) lg += sh[(w * 16 + lr) * 64 + lane];
            const float score = sigmoid_f(lg), key = score + bias;
            int rank = 0;
            for (int j = 0; j < 64; ++j) { const float kj = __shfl(key, j); rank += (kj > key || (kj == key && j < lane)) ? 1 : 0; }
            const bool sel = rank < 8;
            const float ssum = wave_sum(sel ? score : 0.f);
            rnk[rr] = sel ? rank : -1; loc[rr] = 0u;
            if (sel) { tkidx[row * 8 + rank] = lane; tkw[row * 8 + rank] = score / ssum * 2.5f; loc[rr] = atomicAdd(&lcnt[lane], 1u); }
        }
        __syncthreads();
        if (tid < 64) lcnt[64 + tid] = atomicAdd(&cnt[tid], lcnt[tid]);
        __syncthreads();
#pragma unroll
        for (int rr = 0; rr < 2; ++rr) if (rnk[rr] >= 0) slot[(r0 + wv * 2 + rr) * 8 + rnk[rr]] = (int)(lcnt[64 + lane] + loc[rr]);
        __syncthreads();
    }
}

__device__ __forceinline__ void moe_offsets(const Params& p, int* offs) {
    if (opaque((int)threadIdx.x) == 0) { const unsigned* cnt = (const unsigned*)(p.ws + OFF_CTRL) + CW_CNT; int s = 0;
        for (int e = 0; e < 64; ++e) { offs[e] = s; s += (int)cnt[e]; }
        offs[64] = s; offs[65] = s + NTOK; }
    __syncthreads();
}
__device__ __forceinline__ void phase_scatter(const Params& p, int bid, int nb, unsigned char* smem) {
    int* offs = (int*)smem; moe_offsets(p, offs);
    const int* tkidx = (const int*)(p.ws + OFF_TKIDX); const float* tkw = (const float*)(p.ws + OFF_TKW); const int* slot = (const int*)(p.ws + OFF_SLOT);
    int* pos = (int*)(p.ws + OFF_POS); int* stok = (int*)(p.ws + OFF_STOK); float* roww = (float*)(p.ws + OFF_ROWW);
    const int tid = opaque((int)threadIdx.x);
    for (int i = bid * NTHR + tid; i < NTOK * 8; i += nb * NTHR) {
        const int e = tkidx[i], ps = offs[e] + slot[i];
        pos[i] = ps; stok[ps] = i >> 3; roww[ps] = tkw[i];
    }
    for (int t = bid * NTHR + tid; t < NTOK; t += nb * NTHR) { stok[NTOK * 8 + t] = t; roww[NTOK * 8 + t] = 1.f; }
}

__device__ __forceinline__ void phase_moe_gemm(const Params& p, int which, int bid, int nb, unsigned char* smem) {
    int* offs = (int*)(smem + 2 * 128 * GS * 2); int* tst = offs + 72;
    moe_offsets(p, offs);
    const int ntn = which ? 16 : 8;
    if (opaque((int)threadIdx.x) == 0) { int s = 0; for (int e = 0; e < 65; ++e) { tst[e] = s; s += ((offs[e + 1] - offs[e] + 127) >> 7) * ntn; } tst[65] = s; }
    __syncthreads();
    const int total = tst[65];
    const bf16_t* h2 = (const bf16_t*)(p.ws + OFF_H); bf16_t* act = (bf16_t*)(p.ws + OFF_ACT); bf16_t* y = (bf16_t*)(p.ws + OFF_Y);
    const int* stok = (const int*)(p.ws + OFF_STOK); const float* roww = (const float*)(p.ws + OFF_ROWW);
    for (int t = bid; t < total; t += nb) {
        int e = 0; while (t >= tst[e + 1]) ++e;
        const int loc = t - tst[e], mt = (offs[e + 1] - offs[e] + 127) >> 7, m0 = offs[e] + (loc % mt) * 128, n0 = (loc / mt) * 128;
        if (which == 0) {
            ARowGather af{h2, D, stok, offs[e + 1] - 1}; BRowGateUp bf{(const bf16_t*)(p.ws + OFF_GUT) + (size_t)e * 1024 * 2048, 2048}; EpiAct epi{act, offs[e + 1]};
            gemm_tile128(af, bf, 0, 2048, m0, n0, epi, smem);
        } else {
            ARowDirect af{act, EFF}; BRowDirect bf{(const bf16_t*)(p.ws + OFF_DNT) + (size_t)e * 2048 * 512, 512}; EpiY epi{y, roww, offs[e + 1]};
            gemm_tile128(af, bf, 0, 512, m0, n0, epi, smem);
        }
    }
}

__device__ __forceinline__ void phase_final(const Params& p, int bid, int nb, unsigned char* smem) {
    const float* x1 = (const float*)(p.ws + OFF_X1); const float* mod = (const float*)(p.ws + OFF_MOD);
    const bf16_t* y = (const bf16_t*)(p.ws + OFF_Y); const int* pos = (const int*)(p.ws + OFF_POS);
    const int tid_ = opaque((int)threadIdx.x); const int lane = tid_ & 63, wv = tid_ >> 6;
    float* srow = (float*)smem + wv * 2048;
    for (int row = bid * 8 + wv; row < NTOK; row += nb * 8) {
        const int b = row / T;
        const float* gm = mod + b * 12288 + 5 * 2048;
        const int* prow = pos + row * 8; const float* wrow = (const float*)(p.ws + OFF_TKW) + row * 8;
        float ss = 0.f;
#pragma unroll 4
        for (int c = 0; c < 8; ++c) { const int col = (c * 64 + lane) * 4;
            float acc[4] = {0.f, 0.f, 0.f, 0.f};
#pragma unroll
            for (int k = 0; k < 9; ++k) { const int pr = (k < 8) ? prow[k] : (NTOK * 8 + row); const float wk = (k < 8) ? wrow[k] : 1.f; const uint2 u = *(const uint2*)(y + (size_t)pr * D + col);
                acc[0] += wk * bf2f((bf16_t)(u.x & 0xffff)); acc[1] += wk * bf2f((bf16_t)(u.x >> 16)); acc[2] += wk * bf2f((bf16_t)(u.y & 0xffff)); acc[3] += wk * bf2f((bf16_t)(u.y >> 16)); }
            const f32x4 xv = *(const f32x4*)(x1 + (size_t)row * D + col), g = *(const f32x4*)(gm + col);
            f32x4 v;
#pragma unroll
            for (int q = 0; q < 4; ++q) { v[q] = xv[q] + g[q] * acc[q]; ss += v[q] * v[q]; }
            *(f32x4*)(srow + col) = v; }
        ss = wave_sum(ss);
        const float rstd = rsqrtf(ss * (1.f / D) + 1e-6f);
#pragma unroll 1
        for (int c = 0; c < 8; ++c) { const int col = (c * 64 + lane) * 4; const f32x4 w = *(const f32x4*)(p.norm_final_w + col); const f32x4 v = *(const f32x4*)(srow + col);
            f32x4 o;
#pragma unroll
            for (int q = 0; q < 4; ++q) o[q] = v[q] * rstd * w[q];
            *(f32x4*)(p.out + (size_t)row * D + col) = o; }
    }
}

namespace g8 {
#define G8_LAS __attribute__((address_space(3)))
typedef unsigned u32x4 __attribute__((ext_vector_type(4)));
constexpr int BM = 256, BK = 64, HALF = 128, HTB = HALF * BK * 2, STAGE_BYTES = 8 * HTB;
__device__ __forceinline__ int lds_byte(int r, int c) { const int st = (r >> 4) * 2 + (c >> 5), rr = r & 15, cc = c & 31, ob = rr * 64 + cc * 2; return st * 1024 + (ob ^ (((ob >> 9) & 1) << 5)); }
__device__ __forceinline__ void stage_rc(int b, int& R, int& C) { const int st = b / 1024, sb = b % 1024, swz = sb ^ (((sb >> 9) & 1) << 5); R = (st >> 1) * 16 + swz / 64; C = (st & 1) * 32 + (swz % 64) / 2; }
__device__ __forceinline__ int perm32r(int rho) { const int n = rho >> 4, i = rho & 15; return 8 * (i >> 2) + 4 * n + (i & 3); }
__device__ __forceinline__ unsigned cvt_pk_bf16(float lo, float hi) { return pack2(lo, hi); }

struct Unit { int m0, pn, rend, e; };

struct DenseSched { int nM, nN, nwg, G, c;
    __device__ void init(int M, int N, int G_, int c_) { nM = M / BM; nN = N / BM; nwg = nM * nN; G = G_; c = c_; }
    __device__ bool next(int i, Unit& u) const {
        const long L = (long)i * G + c; if (L >= nwg) return false;
        int wgid = (int)L; { const int q = nwg / 8, r = nwg % 8, xcd = wgid % 8, off = wgid / 8; wgid = (xcd < r ? xcd * (q + 1) : r * (q + 1) + (xcd - r) * q) + off; }
        const int nig = 8 * nN, gid = wgid / nig, fm = gid * 8, gsz = (nM - fm) < 8 ? (nM - fm) : 8;
        u.m0 = (fm + ((wgid % nig) % gsz)) * BM; u.pn = (wgid % nig) / gsz; u.rend = 0x7fffffff; u.e = 0; return true; } };
struct MoeSched { const G8_LAS int* tst; const G8_LAS int* offs; int G, c; mutable int ehint; int ntn;
    __device__ bool next(int i, Unit& u) const {
        const int nwg = tst[65]; const int L0 = i * G + c; if (L0 >= nwg) return false;
        int L; { const int q = nwg / 8, r = nwg % 8, xcd = L0 % 8, off = L0 / 8; L = (xcd < r ? xcd * (q + 1) : r * (q + 1) + (xcd - r) * q) + off; }
        int e = (L >= tst[ehint]) ? ehint : 0; while (L >= tst[e + 1]) ++e; ehint = e;
        const int loc = L - tst[e], mt = (offs[e + 1] - offs[e] + 255) >> 8;
        (void)mt; u.m0 = offs[e] + (loc / ntn) * BM; u.pn = loc % ntn; u.rend = offs[e + 1]; u.e = e; return true; } };
struct ADirect { static constexpr bool LOADS = false; unsigned K2; __device__ __forceinline__ unsigned off(const Unit& u, int r) const { return (unsigned)(u.m0 + r) * K2; } };
struct AGather { static constexpr bool LOADS = true; const int* idx; unsigned K2; __device__ __forceinline__ unsigned off(const Unit& u, int r) const { int rr = u.m0 + r; rr = rr < u.rend ? rr : u.rend - 1; return (unsigned)idx[rr] * K2; } };
struct BDense { const char* Bt; size_t tstep; __device__ __forceinline__ const char* base(const Unit& u) const { return Bt + (size_t)u.pn * tstep; } };
struct BGroup { const char* Bt; size_t tstep, estride; __device__ __forceinline__ const char* base(const Unit& u) const { return Bt + (size_t)u.e * estride + (size_t)u.pn * tstep; } };

struct EpiProj8 { static constexpr bool PERM = true; bf16_t* proj; float* small;
    __device__ __forceinline__ void operator()(const f32x4 (&acc)[2][2][4][2], const Unit& u, int wr, int wc, int fr, int fq) const {
#pragma unroll
        for (int ai = 0; ai < 2; ++ai)
#pragma unroll
            for (int m = 0; m < 4; ++m) { const int row = u.m0 + ai * HALF + wr * 64 + m * 16 + fr;
#pragma unroll
                for (int bj = 0; bj < 2; ++bj) { const int col = u.pn * BM + bj * HALF + wc * 32 + 8 * fq; const f32x4 v0 = acc[ai][bj][m][0], v1 = acc[ai][bj][m][1];
                    if (col < C_SMALL) { u32x4 w; w.x = cvt_pk_bf16(v0[0], v0[1]); w.y = cvt_pk_bf16(v0[2], v0[3]); w.z = cvt_pk_bf16(v1[0], v1[1]); w.w = cvt_pk_bf16(v1[2], v1[3]);
                        *(u32x4*)(proj + (size_t)row * PROJ_LD + col) = w; }
                    else if (col < C_SMALL + 40) { float* sp = small + (size_t)row * 64 + (col - C_SMALL); *(f32x4*)sp = v0; *(f32x4*)(sp + 4) = v1; } } }
    } };
struct EpiOut8 { static constexpr bool PERM = false; const float* x; const float* mod; float* x1;
    __device__ __forceinline__ void operator()(const f32x4 (&acc)[2][2][4][2], const Unit& u, int wr, int wc, int fr, int fq) const {
        const float* g = mod + (u.m0 / T) * 12288 + 2 * 2048;
#pragma unroll
        for (int ai = 0; ai < 2; ++ai)
#pragma unroll
            for (int m = 0; m < 4; ++m) { const int row = u.m0 + ai * HALF + wr * 64 + m * 16 + fr;
#pragma unroll
                for (int bj = 0; bj < 2; ++bj)
#pragma unroll
                    for (int n = 0; n < 2; ++n) { const int col = u.pn * BM + bj * HALF + wc * 32 + 16 * n + 4 * fq; const size_t o = (size_t)row * D + col;
                        const f32x4 xv = *(const f32x4*)(x + o), gv = *(const f32x4*)(g + col); *(f32x4*)(x1 + o) = xv + gv * acc[ai][bj][m][n]; } }
    } };
struct EpiAct8 { static constexpr bool PERM = true; bf16_t* act;
    __device__ __forceinline__ void operator()(const f32x4 (&acc)[2][2][4][2], const Unit& u, int wr, int wc, int fr, int fq) const {
#pragma unroll
        for (int ai = 0; ai < 2; ++ai)
#pragma unroll
            for (int m = 0; m < 4; ++m) { const int row = u.m0 + ai * HALF + wr * 64 + m * 16 + fr;
                if (row < u.rend) { float r[8];
#pragma unroll
                    for (int n = 0; n < 2; ++n)
#pragma unroll
                        for (int j = 0; j < 4; ++j) r[4 * n + j] = silu_f(acc[ai][0][m][n][j]) * acc[ai][1][m][n][j];
                    u32x4 w; w.x = cvt_pk_bf16(r[0], r[1]); w.y = cvt_pk_bf16(r[2], r[3]); w.z = cvt_pk_bf16(r[4], r[5]); w.w = cvt_pk_bf16(r[6], r[7]);
                    *(u32x4*)(act + (size_t)row * EFF + u.pn * HALF + wc * 32 + 8 * fq) = w; } }
    } };
struct EpiY8 { static constexpr bool PERM = true; bf16_t* y; const float* roww;
    __device__ __forceinline__ void operator()(const f32x4 (&acc)[2][2][4][2], const Unit& u, int wr, int wc, int fr, int fq) const {
#pragma unroll
        for (int ai = 0; ai < 2; ++ai)
#pragma unroll
            for (int m = 0; m < 4; ++m) { const int row = u.m0 + ai * HALF + wr * 64 + m * 16 + fr;
                if (row < u.rend) {
#pragma unroll
                    for (int bj = 0; bj < 2; ++bj) { const f32x4 v0 = acc[ai][bj][m][0], v1 = acc[ai][bj][m][1];
                        u32x4 w; w.x = cvt_pk_bf16(v0[0], v0[1]); w.y = cvt_pk_bf16(v0[2], v0[3]); w.z = cvt_pk_bf16(v1[0], v1[1]); w.w = cvt_pk_bf16(v1[2], v1[3]);
                        *(u32x4*)(y + (size_t)row * D + u.pn * BM + bj * HALF + wc * 32 + 8 * fq) = w; } } }
    } };

template <class Epi, class Sched, class AOff, class BBase>
__device__ __forceinline__ void gemm_phase(G8_LAS unsigned char* lds, const int K, const Sched& S, const Epi& E, const AOff& AO, const char* Abase, const BBase& BB) {
    const int tid = opaque((int)threadIdx.x), wid = __builtin_amdgcn_readfirstlane(tid >> 6), lane = tid & 63, wr = wid >> 2, wc = wid & 3, fr = lane & 15, fq = lane >> 4;
    const int nt = K / BK;
    int RA[2], CA2[2]; unsigned voffB[2];
#pragma unroll
    for (int i = 0; i < 2; ++i) { int R, C; stage_rc(tid * 16 + i * 8192, R, C); const int Rb = Epi::PERM ? ((R & ~31) + perm32r(R & 31)) : R;
        RA[i] = R; CA2[i] = C * 2; voffB[i] = (unsigned)(Rb * K + C) * 2u; }
    const size_t kstep = (size_t)(BK * 2);
    const size_t hstep = (size_t)HALF * K * 2;
    const unsigned ldsw = (unsigned)wid * 1024u;
    const int aoff = lds_byte(wr * 64 + fr, fq * 8), boff = lds_byte(wc * 32 + fr, fq * 8);
#define G8_SA(b, h) (((b) * 2 + (h)) * HTB)
#define G8_SB(b, h) ((4 + (b) * 2 + (h)) * HTB)
#define G8_STAGE(bufoff, gbase, voff) do { _Pragma("unroll") for (int _i = 0; _i < 2; ++_i) \
        __builtin_amdgcn_global_load_lds((const unsigned*)((const char*)(gbase) + (voff)[_i]), (G8_LAS unsigned*)(lds + (bufoff) + ldsw + _i * 8192), 16, 0, 0); } while (0)
#define G8_LDA(dst, b, h) do { _Pragma("unroll") for (int m = 0; m < 4; ++m) _Pragma("unroll") for (int k = 0; k < 2; ++k) dst[m][k] = *(const G8_LAS bf16x8*)(lds + G8_SA(b, h) + aoff + m * 2048 + k * 1024); } while (0)
#define G8_LDB(dst, b, h) do { _Pragma("unroll") for (int n = 0; n < 2; ++n) _Pragma("unroll") for (int k = 0; k < 2; ++k) dst[n][k] = *(const G8_LAS bf16x8*)(lds + G8_SB(b, h) + boff + n * 2048 + k * 1024); } while (0)
#define G8_MMA(ai, bj, At, Bt) do { __builtin_amdgcn_s_setprio(1); _Pragma("unroll") for (int m = 0; m < 4; ++m) _Pragma("unroll") for (int n = 0; n < 2; ++n) _Pragma("unroll") for (int k = 0; k < 2; ++k) \
        acc[ai][bj][m][n] = __builtin_amdgcn_mfma_f32_16x16x32_bf16(Bt[n][k], At[m][k], acc[ai][bj][m][n], 0, 0, 0); __builtin_amdgcn_s_setprio(0); } while (0)
#define G8_WAIT_V(n) asm volatile("s_waitcnt vmcnt(" #n ")" ::: "memory")
#define G8_WAIT_L(n) asm volatile("s_waitcnt lgkmcnt(" #n ")" ::: "memory")
#define G8_BAR __builtin_amdgcn_s_barrier()
#define G8_SCHED __builtin_amdgcn_sched_barrier(0)
#define G8_AOFF(dst, un) do { _Pragma("unroll") for (int _h = 0; _h < 2; ++_h) _Pragma("unroll") for (int _i = 0; _i < 2; ++_i) dst[_h][_i] = AO.off(un, _h * HALF + RA[_i]) + (unsigned)CA2[_i]; } while (0)
    Unit cur, nxt; int ui = 0;
    if (!S.next(0, cur)) return;
    f32x4 acc[2][2][4][2];
#pragma unroll
    for (int a = 0; a < 2; ++a)
#pragma unroll
        for (int b = 0; b < 2; ++b)
#pragma unroll
            for (int m = 0; m < 4; ++m)
#pragma unroll
                for (int n = 0; n < 2; ++n) acc[a][b][m][n] = (f32x4){0.f, 0.f, 0.f, 0.f};
    bf16x8 At[4][2], B0[2][2], B1[2][2];
    unsigned vA[2][2];
    G8_AOFF(vA, cur);
    asm volatile("s_waitcnt vmcnt(0)" ::: "memory");
    const char* cB = BB.base(cur);
    G8_STAGE(G8_SB(0, 0), cB, voffB); G8_STAGE(G8_SA(0, 0), Abase, vA[0]); G8_STAGE(G8_SB(0, 1), cB + hstep, voffB); G8_STAGE(G8_SA(0, 1), Abase, vA[1]);
    if (wr == 1) G8_BAR;
    G8_WAIT_V(4); G8_BAR;
    G8_STAGE(G8_SB(1, 0), cB + kstep, voffB); G8_STAGE(G8_SA(1, 0), Abase + kstep, vA[0]); G8_STAGE(G8_SB(1, 1), cB + hstep + kstep, voffB);
    G8_WAIT_V(6); G8_BAR;
    for (;;) {
        const bool has_next = S.next(ui + 1, nxt);
        const char* nB = has_next ? BB.base(nxt) : cB;
        for (int t = 0; t < nt; t += 2) {
            const bool last = (t == nt - 2);
            const char* a1 = Abase + (size_t)(t + 1) * kstep;
            const char* a2 = last ? Abase : Abase + (size_t)(t + 2) * kstep; const char* b2 = last ? nB : cB + (size_t)(t + 2) * kstep;
            const char* a3 = a2 + kstep; const char* b3 = b2 + kstep;
            G8_LDB(B0, 0, 0); G8_SCHED; G8_LDA(At, 0, 0); G8_STAGE(G8_SA(1, 1), a1, vA[1]);
            if (last && has_next) { G8_AOFF(vA, nxt); if (AOff::LOADS) asm volatile("s_waitcnt vmcnt(0)" ::: "memory"); }
            G8_WAIT_L(8); G8_BAR; G8_WAIT_L(0); G8_MMA(0, 0, At, B0); G8_BAR; G8_SCHED;
            G8_LDB(B1, 0, 1); G8_STAGE(G8_SB(0, 0), b2, voffB);
            G8_BAR; G8_WAIT_L(0); G8_MMA(0, 1, At, B1); G8_BAR;
            G8_LDA(At, 0, 1); G8_STAGE(G8_SA(0, 0), a2, vA[0]);
            G8_BAR; G8_WAIT_L(0); G8_MMA(1, 0, At, B0); G8_BAR; G8_SCHED;
            G8_STAGE(G8_SB(0, 1), b2 + hstep, voffB);
            G8_WAIT_V(6); G8_BAR; G8_MMA(1, 1, At, B1); G8_BAR;
            G8_LDB(B0, 1, 0); G8_SCHED; G8_LDA(At, 1, 0); G8_STAGE(G8_SA(0, 1), a2, vA[1]);
            G8_WAIT_L(8); G8_BAR; G8_WAIT_L(0); G8_MMA(0, 0, At, B0); G8_BAR; G8_SCHED;
            G8_LDB(B1, 1, 1); G8_STAGE(G8_SB(1, 0), b3, voffB);
            G8_BAR; G8_WAIT_L(0); G8_MMA(0, 1, At, B1); G8_BAR;
            G8_LDA(At, 1, 1); G8_STAGE(G8_SA(1, 0), a3, vA[0]);
            G8_BAR; G8_WAIT_L(0); G8_MMA(1, 0, At, B0); G8_BAR; G8_SCHED;
            G8_STAGE(G8_SB(1, 1), b3 + hstep, voffB);
            G8_WAIT_V(6); G8_BAR; G8_MMA(1, 1, At, B1); G8_BAR;
        }
        E(acc, cur, wr, wc, fr, fq);
        if (!has_next) break;
#pragma unroll
        for (int a = 0; a < 2; ++a)
#pragma unroll
            for (int b = 0; b < 2; ++b)
#pragma unroll
                for (int m = 0; m < 4; ++m)
#pragma unroll
                    for (int n = 0; n < 2; ++n) acc[a][b][m][n] = (f32x4){0.f, 0.f, 0.f, 0.f};
        cur = nxt; cB = nB; ++ui;
    }
    G8_WAIT_V(0);
    if (wr == 0) G8_BAR;
    G8_BAR;
#undef G8_SA
#undef G8_SB
#undef G8_STAGE
#undef G8_LDA
#undef G8_LDB
#undef G8_MMA
#undef G8_WAIT_V
#undef G8_WAIT_L
#undef G8_BAR
#undef G8_SCHED
#undef G8_AOFF
}
}

__device__ __forceinline__ void phase_moe_gemm8(const Params& p, int which, int bid, int nb, unsigned char* smem) {
    int* offs = (int*)(smem + g8::STAGE_BYTES); int* tst = offs + 72;
    moe_offsets(p, offs);
    const int ntn = which ? 8 : 4;
    if (opaque((int)threadIdx.x) == 0) { int s = 0; for (int e = 0; e < 65; ++e) { tst[e] = s; s += ((offs[e + 1] - offs[e] + 255) >> 8) * ntn; } tst[65] = s; }
    __syncthreads();
    g8::MoeSched S{(const G8_LAS int*)tst, (const G8_LAS int*)offs, nb, bid, 0, ntn};
    if (which == 0) {
        g8::EpiAct8 E{(bf16_t*)(p.ws + OFF_ACT)}; g8::AGather AO{(const int*)(p.ws + OFF_STOK), (unsigned)(D * 2)};
        g8::BGroup BB{(const char*)(p.ws + OFF_GUT), (size_t)256 * 2048 * 2, (size_t)1024 * 2048 * 2};
        g8::gemm_phase((G8_LAS unsigned char*)smem, 2048, S, E, AO, (const char*)(p.ws + OFF_H), BB);
    } else {
        g8::EpiY8 E{(bf16_t*)(p.ws + OFF_Y), (const float*)(p.ws + OFF_ROWW)}; g8::ADirect AO{(unsigned)(EFF * 2)};
        g8::BGroup BB{(const char*)(p.ws + OFF_DNT), (size_t)256 * 512 * 2, (size_t)2048 * 512 * 2};
        g8::gemm_phase((G8_LAS unsigned char*)smem, 512, S, E, AO, (const char*)(p.ws + OFF_ACT), BB);
    }
    __syncthreads();
}

constexpr int LDS_BYTES = LDS_BYTES_C;

__global__ void __launch_bounds__(512, 2) k_mega(Params p) {
    const int bid = blockIdx.x, nb = gridDim.x;
    unsigned char* smem = dyn_smem;
    unsigned* ctrl = (unsigned*)(p.ws + OFF_CTRL);
    volatile LAS unsigned* xbw = (volatile LAS unsigned*)(dyn_smem + LDS_BYTES - 16);
    if (threadIdx.x == 0) { xbw[0] = 0u; xbw[1] = 0u; xbw[2] = 0u; xbw[3] = 0u; LAS int* qs = (LAS int*)(dyn_smem + LDS_BYTES - 128); qs[3] = 0; qs[4] = 0; }
    __syncthreads();
    XcdBarrier bar = xcd_barrier_post(ctrl, xbw);
    const float* mod = (const float*)(p.ws + OFF_MOD);
#ifndef REPEAT_PHASE
#define REPEAT_PHASE -1
#endif
#define REP(k) for (int rep_ = 0; rep_ < ((REPEAT_PHASE == (k)) ? 2 : 1); ++rep_, ((REPEAT_PHASE == (k)) && rep_ == 1) ? xcd_barrier(bar) : (void)0)
    REP(0) phase_prologue(p, bid, nb, smem);
    xcd_barrier(bar);
    REP(1) phase_modulate(p.x, p.norm_attn_w, mod, 0, 1, (bf16_t*)(p.ws + OFF_H), bid, nb);
    xcd_barrier(bar);
    if (nb == 256 && bid >= 216) phase_expert_convert(p, &ctrl[CW_Q0 + 128], smem, 48);
    else REP(2) { g8::DenseSched S; S.init(NTOK, PROJ_LD, nb == 256 ? 216 : nb, bid); g8::EpiProj8 E{(bf16_t*)(p.ws + OFF_PROJ), (float*)(p.ws + OFF_SMALL)}; g8::ADirect AO{(unsigned)(D * 2)};
      g8::BDense BB{(const char*)(p.ws + OFF_WINT), (size_t)256 * D * 2};
      g8::gemm_phase((G8_LAS unsigned char*)smem, D, S, E, AO, (const char*)(p.ws + OFF_H), BB); }
    xcd_barrier_work(bar, p, &ctrl[CW_Q0 + 128], smem);
    REP(3) { phase_cmp1(p, bid, nb, smem); phase_gdn_prep(p, bid, nb, smem); }
    xcd_barrier_work(bar, p, &ctrl[CW_Q0 + 128], smem);
    REP(5) phase_cmp2(p, bid, nb, smem);
    xcd_barrier_work(bar, p, &ctrl[CW_Q0 + 128], smem);
    REP(6) {
    for (int j = bid; j < 16; j += nb) phase_gdn_scan(p, j, smem);
    constexpr int CONV_FIRST = 80;
    const bool conv_first = (nb >= 192) && (bid >= nb - CONV_FIRST);
    for (int stg = 0; stg < 2; ++stg) {
        if ((stg == 0) == conv_first) phase_expert_convert(p, &ctrl[CW_Q0 + 128], smem);
        else {
            LAS int* qslot = (LAS int*)(dyn_smem + LDS_BYTES - 32);
            for (;;) {
                __syncthreads();
                if (threadIdx.x == 0) *qslot = (int)__hip_atomic_fetch_add(&ctrl[CW_Q0 + 64 * rep_], 1u, __ATOMIC_RELAXED, __HIP_MEMORY_SCOPE_AGENT);
                __syncthreads();
                const int i = *qslot;
                if (i >= 256) break;
                nsa_job(p, ((i & 3) << 6) | (63 - (i >> 2)), smem);
            }
        }
    }
    }
    xcd_barrier_work(bar, p, &ctrl[CW_Q0 + 128], smem);
    REP(13) phase_gdn_out(p, bid, nb, smem);
    xcd_barrier(bar);
    REP(7) { g8::DenseSched S; S.init(NTOK, D, nb, bid); g8::EpiOut8 E{p.x, mod, (float*)(p.ws + OFF_X1)}; g8::ADirect AO{(unsigned)(D * 2)};
      g8::BDense BB{(const char*)(p.ws + OFF_WOUTT), (size_t)256 * D * 2};
      g8::gemm_phase((G8_LAS unsigned char*)smem, D, S, E, AO, (const char*)(p.ws + OFF_YCAT), BB); }
    xcd_barrier(bar);
    REP(8) phase_router(p, bid, nb, smem, (REPEAT_PHASE == 8 && rep_ == 0) ? 128 : 0);
    xcd_barrier(bar);
    REP(9) phase_scatter(p, bid, nb, smem);
    xcd_barrier(bar);
    REP(10) phase_moe_gemm8(p, 0, bid, nb, smem);
    xcd_barrier(bar);
    REP(11) phase_moe_gemm8(p, 1, bid, nb, smem);
    xcd_barrier(bar);
    REP(12) phase_final(p, bid, nb, smem);
}

extern "C" void kernel_launch(void* const* d_in, const int* in_sizes, int n_in, void* d_out, int out_size, void* d_ws, size_t ws_size, hipStream_t stream) {
    (void)in_sizes; (void)n_in; (void)out_size; (void)ws_size;
    Params p{};
    const float** f = (const float**)&p;
    for (int i = 0; i < 27; ++i) f[i] = (const float*)d_in[i];
    p.out = (float*)d_out; p.ws = (unsigned char*)d_ws;
    static int grid = 0;
    if (!grid) {
        int dev = 0, cus = 0, per_cu = 0;
        (void)hipGetDevice(&dev);
        (void)hipDeviceGetAttribute(&cus, hipDeviceAttributeMultiprocessorCount, dev);
        (void)hipFuncSetAttribute((const void*)k_mega, hipFuncAttributeMaxDynamicSharedMemorySize, LDS_BYTES);
        (void)hipOccupancyMaxActiveBlocksPerMultiprocessor(&per_cu, (const void*)k_mega, NTHR, LDS_BYTES);
        if (cus <= 0) cus = 256;
        grid = cus;
        (void)per_cu;
    }
    (void)hipMemsetAsync((char*)d_ws + OFF_CTRL, 0, CTRL_BYTES, stream);
    hipLaunchKernelGGL(k_mega, dim3(grid), dim3(NTHR), LDS_BYTES, stream, p);
}
```
